# Optimizing an MI355X kernel written in HIP

```python
import math
import jax, jax.numpy as jnp
from jax import lax
import numpy as np

D_MODEL = 2048
BATCH = 4
SEQ = 2048
DEPTH = 1

MOBA_HEADS = 8
HEAD_DIM = 128
MOBA_BLOCK = 256
MOBA_TOPK = 3
MLA_HEADS = 8
MLA_Q_LORA = 512
MLA_KV_LORA = 256
MLA_NOPE = 128
MLA_ROPE = 64
MLA_V = 128
ROPE_THETA = 10000.0
MEM_TOKENS = 256
MEM_HEADS = 4
MEM_HEAD_DIM = 128
N_BUCKETS = 32
MAX_DISTANCE = 128
Q_BLOCK = 128
EPS = 1e-6

MOBA_W = MOBA_HEADS * HEAD_DIM
MLA_W = MLA_HEADS * MLA_V
MEM_W = MEM_HEADS * MEM_HEAD_DIM
IN_SPLITS = (MOBA_W, MOBA_W, MOBA_W, MOBA_W,
             MLA_Q_LORA, MLA_KV_LORA, MLA_ROPE, MLA_W,
             MEM_W, MEM_W,
             D_MODEL, D_MODEL, D_MODEL)
IN_WIDTH = sum(IN_SPLITS)

kernel_name = "hybrid_moba_mla_memory_gated_block"


def rms_norm(x, g):
    xf = x.astype(jnp.float32)
    y = xf * lax.rsqrt(jnp.mean(xf * xf, axis=-1, keepdims=True) + EPS)
    return (y * g.astype(jnp.float32)).astype(x.dtype)


def rope(x, pos):
    half = x.shape[-1] // 2
    inv = ROPE_THETA ** (-jnp.arange(half, dtype=jnp.float32) / half)
    ang = pos.astype(jnp.float32)[:, None] * inv[None, :]
    cos = jnp.cos(ang)[None, :, None, :]
    sin = jnp.sin(ang)[None, :, None, :]
    x1, x2 = x[..., :half], x[..., half:]
    return jnp.concatenate([x1 * cos - x2 * sin, x2 * cos + x1 * sin], axis=-1).astype(x.dtype)


def t5_bucket(dist):
    n = jnp.maximum(dist, 0)
    max_exact = N_BUCKETS // 2
    nf = jnp.maximum(n, 1).astype(jnp.float32)
    large = max_exact + (jnp.log(nf / max_exact) / math.log(MAX_DISTANCE / max_exact)
                         * (N_BUCKETS - max_exact)).astype(jnp.int32)
    large = jnp.minimum(large, N_BUCKETS - 1)
    return jnp.where(n < max_exact, n, large)


def moba_attention(q, k, v, rel_bias):
    B, S, H, dh = q.shape
    nb = -(-S // MOBA_BLOCK)
    s_pad = nb * MOBA_BLOCK
    pad = ((0, 0), (0, s_pad - S), (0, 0), (0, 0))
    kb = jnp.pad(k, pad).reshape(B, nb, MOBA_BLOCK, H, dh).transpose(0, 3, 1, 2, 4)
    vb = jnp.pad(v, pad).reshape(B, nb, MOBA_BLOCK, H, dh).transpose(0, 3, 1, 2, 4)
    k_mean = jnp.mean(kb.astype(jnp.float32), axis=3)
    qh = q.transpose(0, 2, 1, 3)
    q_blk = jnp.arange(S, dtype=jnp.int32) // MOBA_BLOCK
    gate = jnp.einsum('bhsd,bhnd->bhsn', qh.astype(jnp.float32), k_mean)
    past = jnp.arange(nb, dtype=jnp.int32)[None, :] < q_blk[:, None]
    gate = jnp.where(past[None, None], gate, -jnp.inf)
    ksel = min(MOBA_TOPK, nb)
    _, sel = lax.top_k(gate, ksel)
    sel = sel.astype(jnp.int32)
    sel_valid = sel < q_blk[None, None, :, None]

    nc = S // Q_BLOCK
    n_items = B * H * nc
    q_items = qh.reshape(n_items, Q_BLOCK, dh)
    sel_items = sel.reshape(n_items, Q_BLOCK, ksel)
    valid_items = sel_valid.reshape(n_items, Q_BLOCK, ksel)
    ids = jnp.arange(n_items, dtype=jnp.int32)
    bh_ids = ids // nc
    c_ids = ids % nc
    h_ids = bh_ids % H
    kb_flat = kb.reshape(B * H, nb, MOBA_BLOCK, dh)
    vb_flat = vb.reshape(B * H, nb, MOBA_BLOCK, dh)
    scale = HEAD_DIM ** -0.5
    blk_off = jnp.arange(MOBA_BLOCK, dtype=jnp.int32)

    def one(args):
        qc, selc, validc, bh, c, hh = args
        kbh = kb_flat[bh]
        vbh = vb_flat[bh]
        qpos = c * Q_BLOCK + jnp.arange(Q_BLOCK, dtype=jnp.int32)
        own = (c * Q_BLOCK) // MOBA_BLOCK
        k_own, v_own = kbh[own], vbh[own]
        k_sel, v_sel = kbh[selc], vbh[selc]
        l_sel = jnp.einsum('qd,qjkd->qjk', qc, k_sel).reshape(Q_BLOCK, ksel * MOBA_BLOCK)
        l_own = jnp.einsum('qd,kd->qk', qc, k_own)
        kpos_sel = (selc[:, :, None] * MOBA_BLOCK + blk_off).reshape(Q_BLOCK, ksel * MOBA_BLOCK)
        kpos_own = own * MOBA_BLOCK + blk_off
        kpos = jnp.concatenate([kpos_sel, jnp.broadcast_to(kpos_own, (Q_BLOCK, MOBA_BLOCK))], axis=-1)
        bias = rel_bias[t5_bucket(qpos[:, None] - kpos), hh].astype(jnp.float32)
        logits = jnp.concatenate([l_sel, l_own], axis=-1).astype(jnp.float32) * scale + bias
        m_sel = jnp.broadcast_to(validc[:, :, None], (Q_BLOCK, ksel, MOBA_BLOCK)).reshape(Q_BLOCK, ksel * MOBA_BLOCK)
        m_own = kpos_own[None, :] <= qpos[:, None]
        mask = jnp.concatenate([m_sel, m_own], axis=-1)
        p = jax.nn.softmax(jnp.where(mask, logits, -jnp.inf), axis=-1).astype(v.dtype)
        p_sel, p_own = p[:, :ksel * MOBA_BLOCK], p[:, ksel * MOBA_BLOCK:]
        return (jnp.einsum('qk,qkd->qd', p_sel, v_sel.reshape(Q_BLOCK, ksel * MOBA_BLOCK, dh))
                + jnp.einsum('qk,kd->qd', p_own, v_own))

    out = lax.map(one, (q_items, sel_items, valid_items, bh_ids, c_ids, h_ids))
    return out.reshape(B, H, S, dh).transpose(0, 2, 1, 3).reshape(B, S, H * dh)


def causal_attention(q, k, v):
    B, S, H, dk = q.shape
    dv = v.shape[-1]
    nc = S // Q_BLOCK
    qb = q.reshape(B, nc, Q_BLOCK, H, dk).transpose(1, 0, 2, 3, 4)
    kpos = jnp.arange(S, dtype=jnp.int32)
    scale = dk ** -0.5

    def blk(args):
        qc, c = args
        qpos = c * Q_BLOCK + jnp.arange(Q_BLOCK, dtype=jnp.int32)
        logits = jnp.einsum('bqhd,bkhd->bhqk', qc, k).astype(jnp.float32) * scale
        logits = jnp.where(kpos[None, :] <= qpos[:, None], logits, -jnp.inf)
        p = jax.nn.softmax(logits, axis=-1).astype(v.dtype)
        return jnp.einsum('bhqk,bkhd->bqhd', p, v)

    out = lax.map(blk, (qb, jnp.arange(nc, dtype=jnp.int32)))
    return out.transpose(1, 0, 2, 3, 4).reshape(B, S, H * dv)


def memory_attention(q, k, v):
    B, S, H, d = q.shape
    logits = jnp.einsum('bshd,bmhd->bhsm', q, k).astype(jnp.float32) * (d ** -0.5)
    p = jax.nn.softmax(logits, axis=-1).astype(v.dtype)
    return jnp.einsum('bhsm,bmhd->bshd', p, v).reshape(B, S, H * d)


def setup_inputs(seed: int = 0) -> dict:
    key = jax.random.key(seed)
    ks = jax.random.split(key, 18)
    f32 = jnp.float32

    def nrm(k, shape, fan_in):
        return jax.random.normal(k, shape, f32) * fan_in ** -0.5

    def gain(k, shape):
        return 1.0 + 0.1 * jax.random.normal(k, shape, f32)

    L = DEPTH
    return {
        "x": jax.random.normal(ks[0], (BATCH, SEQ, D_MODEL), f32),
        "mem": jax.random.normal(ks[1], (BATCH, MEM_TOKENS, D_MODEL), f32),
        "g_norm": gain(ks[2], (L, D_MODEL)),
        "w_in": nrm(ks[3], (L, D_MODEL, IN_WIDTH), D_MODEL),
        "g_cq": gain(ks[4], (L, MLA_Q_LORA)),
        "w_uq": nrm(ks[5], (L, MLA_Q_LORA, MLA_HEADS * (MLA_NOPE + MLA_ROPE)), MLA_Q_LORA),
        "g_ckv": gain(ks[6], (L, MLA_KV_LORA)),
        "w_ukv": nrm(ks[7], (L, MLA_KV_LORA, MLA_HEADS * (MLA_NOPE + MLA_V)), MLA_KV_LORA),
        "g_mem": gain(ks[8], (L, D_MODEL)),
        "w_mem_kv": nrm(ks[9], (L, D_MODEL, 2 * MEM_W), D_MODEL),
        "rel_bias": 0.5 * jax.random.normal(ks[10], (N_BUCKETS, MOBA_HEADS), f32),
        "w_p_moba": nrm(ks[11], (L, MOBA_W, D_MODEL), MOBA_W),
        "w_p_mla": nrm(ks[12], (L, MLA_W, D_MODEL), MLA_W),
        "w_p_mem": nrm(ks[13], (L, MEM_W, D_MODEL), MEM_W),
        "w_out": nrm(ks[14], (L, D_MODEL, D_MODEL), D_MODEL),
        "g_final": gain(ks[15], (D_MODEL,)),
    }


def reference(x, mem, g_norm, w_in, g_cq, w_uq, g_ckv, w_ukv, g_mem, w_mem_kv, rel_bias,
              w_p_moba, w_p_mla, w_p_mem, w_out, g_final):
    B, S, _ = x.shape
    M = mem.shape[1]
    pos = jnp.arange(S, dtype=jnp.int32)
    offsets = [int(o) for o in np.cumsum(IN_SPLITS)[:-1]]
    for l in range(DEPTH):
        h = rms_norm(x, g_norm[l])
        u = h @ w_in[l]
        (q_a, k_a, v_a, z_a, c_q, c_kv, k_r, z_b, q_m, z_m,
         gl_a, gl_b, gl_m) = jnp.split(u, offsets, axis=-1)

        o_a = moba_attention(q_a.reshape(B, S, MOBA_HEADS, HEAD_DIM),
                             k_a.reshape(B, S, MOBA_HEADS, HEAD_DIM),
                             v_a.reshape(B, S, MOBA_HEADS, HEAD_DIM), rel_bias)

        q_b = (rms_norm(c_q, g_cq[l]) @ w_uq[l]).reshape(B, S, MLA_HEADS, MLA_NOPE + MLA_ROPE)
        q_b = jnp.concatenate([q_b[..., :MLA_NOPE], rope(q_b[..., MLA_NOPE:], pos)], axis=-1)
        kv_b = (rms_norm(c_kv, g_ckv[l]) @ w_ukv[l]).reshape(B, S, MLA_HEADS, MLA_NOPE + MLA_V)
        k_rope = jnp.broadcast_to(rope(k_r[:, :, None, :], pos), (B, S, MLA_HEADS, MLA_ROPE))
        k_b = jnp.concatenate([kv_b[..., :MLA_NOPE], k_rope], axis=-1)
        o_b = causal_attention(q_b, k_b, kv_b[..., MLA_NOPE:])

        mkv = rms_norm(mem, g_mem[l]) @ w_mem_kv[l]
        k_m = mkv[..., :MEM_W].reshape(B, M, MEM_HEADS, MEM_HEAD_DIM)
        v_m = mkv[..., MEM_W:].reshape(B, M, MEM_HEADS, MEM_HEAD_DIM)
        o_m = memory_attention(q_m.reshape(B, S, MEM_HEADS, MEM_HEAD_DIM), k_m, v_m)

        p_a = (o_a * jax.nn.silu(z_a)) @ w_p_moba[l]
        p_b = (o_b * jax.nn.silu(z_b)) @ w_p_mla[l]
        p_m = (o_m * jax.nn.silu(z_m)) @ w_p_mem[l]
        y = jax.nn.sigmoid(gl_a) * p_a + jax.nn.sigmoid(gl_b) * p_b + jax.nn.sigmoid(gl_m) * p_m
        x = x + y @ w_out[l]
    return rms_norm(x, g_final)
```

```cpp
#include <hip/hip_runtime.h>
#include <cstdio>
#include <cstdint>
#include <cmath>

namespace {
constexpr int D_MODEL = 2048, BATCH = 4, SEQ = 2048;
constexpr int IN_WIDTH = 13120;
constexpr int OFF_QA = 0, OFF_KA = 1024, OFF_VA = 2048, OFF_ZA = 3072, OFF_CQ = 4096, OFF_CKV = 4608, OFF_KR = 4864, OFF_ZB = 4928,
              OFF_QM = 5952, OFF_ZM = 6464, OFF_GLA = 6976, OFF_GLB = 9024, OFF_GLM = 11072;
constexpr float EPS = 1e-6f;

__device__ const unsigned char T5_BUCKET[128] = {
    0, 1, 2, 3, 4, 5, 6, 7, 8, 9, 10, 11, 12, 13, 14, 15, 16, 16, 16, 17, 17, 18, 18, 18, 19, 19, 19, 20, 20, 20, 20, 21, 21, 21, 21, 22, 22, 22, 22, 22,
    23, 23, 23, 23, 23, 23, 24, 24, 24, 24, 24, 24, 25, 25, 25, 25, 25, 25, 25, 26, 26, 26, 26, 26, 26, 26, 26, 27, 27, 27, 27, 27, 27, 27, 27, 27, 27,
    28, 28, 28, 28, 28, 28, 28, 28, 28, 28, 29, 29, 29, 29, 29, 29, 29, 29, 29, 29, 29, 29, 30, 30, 30, 30, 30, 30, 30, 30, 30, 30, 30, 30, 30, 30,
    31, 31, 31, 31, 31, 31, 31, 31, 31, 31, 31, 31, 31, 31};

__device__ __forceinline__ float block_sum(float v, float* red) {
    for (int o = 32; o > 0; o >>= 1) v += __shfl_xor(v, o);
    __syncthreads();
    if ((threadIdx.x & 63) == 0) red[threadIdx.x >> 6] = v;
    __syncthreads();
    return red[0] + red[1] + red[2] + red[3];
}
__device__ __forceinline__ float block_max(float v, float* red) {
    for (int o = 32; o > 0; o >>= 1) v = fmaxf(v, __shfl_xor(v, o));
    __syncthreads();
    if ((threadIdx.x & 63) == 0) red[threadIdx.x >> 6] = v;
    __syncthreads();
    return fmaxf(fmaxf(red[0], red[1]), fmaxf(red[2], red[3]));
}

__global__ void __launch_bounds__(256) rmsnorm_k(const float* x, int ldx, const float* g, float* y, int ldy, int n) {
    __shared__ float red[4];
    const float* xr = x + (size_t)blockIdx.x * ldx;
    float s = 0.f;
    for (int i = threadIdx.x; i < n; i += 256) { float v = xr[i]; s += v * v; }
    s = block_sum(s, red);
    const float r = 1.0f / sqrtf(s / (float)n + EPS);
    float* yr = y + (size_t)blockIdx.x * ldy;
    for (int i = threadIdx.x; i < n; i += 256) yr[i] = xr[i] * r * g[i];
}

__global__ void __launch_bounds__(256) gemm_f32(const float* A, int lda, const float* B, int ldb, float* C, int ldc, int K) {
    __shared__ float As[16][65];
    __shared__ float Bs[16][64];
    const int tx = threadIdx.x & 15, ty = threadIdx.x >> 4;
    const int row0 = blockIdx.y * 64, col0 = blockIdx.x * 64;
    float acc[4][4];
#pragma unroll
    for (int i = 0; i < 4; ++i)
#pragma unroll
        for (int j = 0; j < 4; ++j) acc[i][j] = 0.f;
    for (int k0 = 0; k0 < K; k0 += 16) {
#pragma unroll
        for (int i = 0; i < 4; ++i) {
            const int idx = threadIdx.x + i * 256;
            { const int r = idx >> 4, c = idx & 15; As[c][r] = A[(size_t)(row0 + r) * lda + k0 + c]; }
            { const int r = idx >> 6, c = idx & 63; Bs[r][c] = B[(size_t)(k0 + r) * ldb + col0 + c]; }
        }
        __syncthreads();
#pragma unroll
        for (int kk = 0; kk < 16; ++kk) {
            float a[4], b[4];
#pragma unroll
            for (int i = 0; i < 4; ++i) a[i] = As[kk][ty * 4 + i];
#pragma unroll
            for (int j = 0; j < 4; ++j) b[j] = Bs[kk][tx * 4 + j];
#pragma unroll
            for (int i = 0; i < 4; ++i)
#pragma unroll
                for (int j = 0; j < 4; ++j) acc[i][j] = fmaf(a[i], b[j], acc[i][j]);
        }
        __syncthreads();
    }
#pragma unroll
    for (int i = 0; i < 4; ++i)
#pragma unroll
        for (int j = 0; j < 4; ++j) C[(size_t)(row0 + ty * 4 + i) * ldc + col0 + tx * 4 + j] = acc[i][j];
}

__global__ void rope_k(const float* src, int lds_, float* x, int ld, int nheads, int hstride, int rows) {
    const int idx = blockIdx.x * blockDim.x + threadIdx.x;
    const int i = idx & 31, hh = (idx >> 5) % nheads, row = (idx >> 5) / nheads;
    if (row >= rows) return;
    const float inv = powf(10000.0f, -(float)i / 32.0f);
    const float ang = (float)row * inv;
    const float c = cosf(ang), s = sinf(ang);
    float* p = x + (size_t)row * ld + hh * hstride;
    const float* ps = src + (size_t)row * lds_ + hh * hstride;
    const float x1 = ps[i], x2 = ps[i + 32];
    p[i] = x1 * c - x2 * s; p[i + 32] = x2 * c + x1 * s;
}

__global__ void kmean_k(const float* u, float* kmean) {
    const int n = blockIdx.x, h = blockIdx.y, d = threadIdx.x;
    float s = 0.f;
    for (int t = 0; t < 256; ++t) s += u[(size_t)(n * 256 + t) * IN_WIDTH + OFF_KA + h * 128 + d];
    kmean[(h * 8 + n) * 128 + d] = s * (1.0f / 256.0f);
}

__device__ __forceinline__ float silu_f(float z) { return z / (1.0f + expf(-z)); }
__device__ __forceinline__ float sigmoid_f(float z) { return 1.0f / (1.0f + expf(-z)); }

__global__ void __launch_bounds__(256) moba_k(const float* u, const float* kmean, const float* rel_bias, float* ga) {
    __shared__ float q[128];
    __shared__ float p[1024];
    __shared__ float red[4];
    __shared__ float gate[8];
    __shared__ int sel[3];
    __shared__ int nsel_s;
    __shared__ float part[128];
    const int s = blockIdx.x, h = blockIdx.y, tid = threadIdx.x;
    const int qblk = s >> 8;
    if (tid < 128) q[tid] = u[(size_t)s * IN_WIDTH + OFF_QA + h * 128 + tid];
    __syncthreads();
    if (tid < 8) {
        float g = -INFINITY;
        if (tid < qblk) { g = 0.f; for (int d = 0; d < 128; ++d) g += q[d] * kmean[(h * 8 + tid) * 128 + d]; }
        gate[tid] = g;
    }
    __syncthreads();
    if (tid == 0) {
        const int ns = qblk < 3 ? qblk : 3;
        for (int j = 0; j < 3; ++j) {
            int best = 0;
            if (j < ns) {
                float bv = -INFINITY;
                for (int i = 0; i < 8; ++i) { const float gi = gate[i]; if (i < qblk && gi > bv) { bv = gi; best = i; } }
                gate[best] = -INFINITY;
            }
            sel[j] = best;
        }
        nsel_s = ns;
    }
    __syncthreads();
    const int nsel = nsel_s;
    const float scale = 0.08838834764831845f;
    float lg[4]; float mx = -INFINITY;
#pragma unroll
    for (int j = 0; j < 4; ++j) {
        bool valid; int kpos;
        if (j < 3) { valid = j < nsel; kpos = sel[j] * 256 + tid; }
        else { kpos = qblk * 256 + tid; valid = kpos <= s; }
        float l = -INFINITY;
        if (valid) {
            const float* kr = u + (size_t)kpos * IN_WIDTH + OFF_KA + h * 128;
            float a = 0.f; for (int d = 0; d < 128; ++d) a += q[d] * kr[d];
            const int dist = s - kpos; const int bk = dist < 128 ? (int)T5_BUCKET[dist] : 31;
            l = a * scale + rel_bias[bk * 8 + h];
        }
        lg[j] = l; mx = fmaxf(mx, l);
    }
    mx = block_max(mx, red);
    float sm = 0.f;
#pragma unroll
    for (int j = 0; j < 4; ++j) { const float e = (lg[j] == -INFINITY) ? 0.f : expf(lg[j] - mx); lg[j] = e; sm += e; }
    sm = block_sum(sm, red);
    const float inv = 1.0f / sm;
#pragma unroll
    for (int j = 0; j < 4; ++j) p[j * 256 + tid] = lg[j] * inv;
    __syncthreads();
    const int d = tid & 127, half = tid >> 7;
    float o = 0.f;
    for (int jj = 0; jj < 2; ++jj) {
        const int j = half * 2 + jj;
        const int blk = (j < 3) ? sel[j] : qblk;
        if (j < 3 && j >= nsel) continue;
        const float* vb = u + (size_t)(blk * 256) * IN_WIDTH + OFF_VA + h * 128 + d;
        for (int t = 0; t < 256; ++t) { const float pv = p[j * 256 + t]; if (pv != 0.f) o += pv * vb[(size_t)t * IN_WIDTH]; }
    }
    if (half == 1) part[d] = o;
    __syncthreads();
    if (half == 0) {
        o += part[d];
        const float z = u[(size_t)s * IN_WIDTH + OFF_ZA + h * 128 + d];
        ga[(size_t)s * 1024 + h * 128 + d] = o * silu_f(z);
    }
}

__global__ void __launch_bounds__(256) mla_k(const float* qb, const float* kvb, const float* krope, const float* u, float* gb) {
    __shared__ float q[192];
    __shared__ float p[2048];
    __shared__ float red[4];
    __shared__ float part[128];
    const int s = blockIdx.x, h = blockIdx.y, tid = threadIdx.x;
    if (tid < 192) q[tid] = qb[(size_t)s * 1536 + h * 192 + tid];
    __syncthreads();
    const float scale = 0.07216878364870322f;
    float mx = -INFINITY;
    for (int k = tid; k <= s; k += 256) {
        const float* kn = kvb + (size_t)k * 2048 + h * 256;
        const float* kr = krope + (size_t)k * 64;
        float a = 0.f;
        for (int d = 0; d < 128; ++d) a += q[d] * kn[d];
        for (int d = 0; d < 64; ++d) a += q[128 + d] * kr[d];
        a *= scale; p[k] = a; mx = fmaxf(mx, a);
    }
    mx = block_max(mx, red);
    float sm = 0.f;
    for (int k = tid; k <= s; k += 256) { const float e = expf(p[k] - mx); p[k] = e; sm += e; }
    sm = block_sum(sm, red);
    const float inv = 1.0f / sm;
    const int d = tid & 127, half = tid >> 7;
    float o = 0.f;
    for (int k = half; k <= s; k += 2) o += p[k] * kvb[(size_t)k * 2048 + h * 256 + 128 + d];
    if (half == 1) part[d] = o;
    __syncthreads();
    if (half == 0) {
        o = (o + part[d]) * inv;
        const float z = u[(size_t)s * IN_WIDTH + OFF_ZB + h * 128 + d];
        gb[(size_t)s * 1024 + h * 128 + d] = o * silu_f(z);
    }
}

__global__ void __launch_bounds__(256) mem_k(const float* u, const float* mkv, float* gm) {
    __shared__ float q[128];
    __shared__ float p[256];
    __shared__ float red[4];
    __shared__ float part[128];
    const int s = blockIdx.x, h = blockIdx.y, tid = threadIdx.x;
    if (tid < 128) q[tid] = u[(size_t)s * IN_WIDTH + OFF_QM + h * 128 + tid];
    __syncthreads();
    const float scale = 0.08838834764831845f;
    const float* kr = mkv + (size_t)tid * 1024 + h * 128;
    float a = 0.f; for (int d = 0; d < 128; ++d) a += q[d] * kr[d];
    a *= scale;
    const float mx = block_max(a, red);
    const float e = expf(a - mx);
    const float sm = block_sum(e, red);
    p[tid] = e / sm;
    __syncthreads();
    const int d = tid & 127, half = tid >> 7;
    float o = 0.f;
    for (int k = half * 128; k < half * 128 + 128; ++k) o += p[k] * mkv[(size_t)k * 1024 + 512 + h * 128 + d];
    if (half == 1) part[d] = o;
    __syncthreads();
    if (half == 0) {
        o += part[d];
        const float z = u[(size_t)s * IN_WIDTH + OFF_ZM + h * 128 + d];
        gm[(size_t)s * 512 + h * 128 + d] = o * silu_f(z);
    }
}

__global__ void merge_k(const float* u, const float* pa, const float* pb, const float* pm, float* y) {
    const size_t idx = (size_t)blockIdx.x * blockDim.x + threadIdx.x;
    const int c = (int)(idx & 2047); const size_t s = idx >> 11;
    const float* ur = u + s * IN_WIDTH;
    y[idx] = sigmoid_f(ur[OFF_GLA + c]) * pa[idx] + sigmoid_f(ur[OFF_GLB + c]) * pb[idx] + sigmoid_f(ur[OFF_GLM + c]) * pm[idx];
}

__global__ void __launch_bounds__(256) final_k(const float* x, const float* xo, const float* g, float* out) {
    __shared__ float red[4];
    const size_t base = (size_t)blockIdx.x * D_MODEL;
    float v[8]; float s = 0.f;
#pragma unroll
    for (int i = 0; i < 8; ++i) { const int c = threadIdx.x + i * 256; v[i] = x[base + c] + xo[base + c]; s += v[i] * v[i]; }
    s = block_sum(s, red);
    const float r = 1.0f / sqrtf(s / (float)D_MODEL + EPS);
#pragma unroll
    for (int i = 0; i < 8; ++i) { const int c = threadIdx.x + i * 256; out[base + c] = v[i] * r * g[c]; }
}

void gemm(const float* A, int lda, const float* B, int ldb, float* C, int ldc, int M, int N, int K, hipStream_t st) {
    gemm_f32<<<dim3(N / 64, M / 64), 256, 0, st>>>(A, lda, B, ldb, C, ldc, K);
}
}

extern "C" void kernel_launch(void* const* d_in, const int* in_sizes, int n_in, void* d_out, int out_size, void* d_ws, size_t ws_size,
                              hipStream_t stream) {
    const float* x = (const float*)d_in[0];
    const float* mem = (const float*)d_in[1];
    const float* g_norm = (const float*)d_in[2];
    const float* w_in = (const float*)d_in[3];
    const float* g_cq = (const float*)d_in[4];
    const float* w_uq = (const float*)d_in[5];
    const float* g_ckv = (const float*)d_in[6];
    const float* w_ukv = (const float*)d_in[7];
    const float* g_mem = (const float*)d_in[8];
    const float* w_mem_kv = (const float*)d_in[9];
    const float* rel_bias = (const float*)d_in[10];
    const float* w_p_moba = (const float*)d_in[11];
    const float* w_p_mla = (const float*)d_in[12];
    const float* w_p_mem = (const float*)d_in[13];
    const float* w_out = (const float*)d_in[14];
    const float* g_final = (const float*)d_in[15];
    float* out = (float*)d_out;

    float* w = (float*)d_ws;
    size_t o = 0;
    auto take = [&](size_t n) { float* p = w + o; o += (n + 63) & ~(size_t)63; return p; };
    const int S = SEQ;
    float* h = take((size_t)S * 2048);
    float* u = take((size_t)S * IN_WIDTH);
    float* cqn = take((size_t)S * 512);
    float* ckvn = take((size_t)S * 256);
    float* qb = take((size_t)S * 1536);
    float* kvb = take((size_t)S * 2048);
    float* krope = take((size_t)S * 64);
    float* hm = take((size_t)256 * 2048);
    float* mkv = take((size_t)256 * 1024);
    float* kmean = take(8 * 8 * 128);
    float* ga = take((size_t)S * 1024);
    float* gb = take((size_t)S * 1024);
    float* gm = take((size_t)S * 512);
    float* pa = take((size_t)S * 2048);
    float* pb = take((size_t)S * 2048);
    float* pm = take((size_t)S * 2048);
    float* y = take((size_t)S * 2048);
    float* xo = take((size_t)S * 2048);
    if (o * 4 > ws_size) { fprintf(stderr, "workspace too small: need %zu have %zu\n", o * 4, ws_size); return; }

    for (int b = 0; b < BATCH; ++b) {
        const float* xb = x + (size_t)b * S * D_MODEL;
        const float* memb = mem + (size_t)b * 256 * D_MODEL;
        rmsnorm_k<<<S, 256, 0, stream>>>(xb, D_MODEL, g_norm, h, D_MODEL, D_MODEL);
        gemm(h, D_MODEL, w_in, IN_WIDTH, u, IN_WIDTH, S, IN_WIDTH, D_MODEL, stream);
        rmsnorm_k<<<S, 256, 0, stream>>>(u + OFF_CQ, IN_WIDTH, g_cq, cqn, 512, 512);
        rmsnorm_k<<<S, 256, 0, stream>>>(u + OFF_CKV, IN_WIDTH, g_ckv, ckvn, 256, 256);
        gemm(cqn, 512, w_uq, 1536, qb, 1536, S, 1536, 512, stream);
        gemm(ckvn, 256, w_ukv, 2048, kvb, 2048, S, 2048, 256, stream);
        rope_k<<<(S * 8 * 32) / 256, 256, 0, stream>>>(qb + 128, 1536, qb + 128, 1536, 8, 192, S);
        rope_k<<<(S * 1 * 32) / 256, 256, 0, stream>>>(u + OFF_KR, IN_WIDTH, krope, 64, 1, 0, S);
        rmsnorm_k<<<256, 256, 0, stream>>>(memb, D_MODEL, g_mem, hm, D_MODEL, D_MODEL);
        gemm(hm, D_MODEL, w_mem_kv, 1024, mkv, 1024, 256, 1024, D_MODEL, stream);
        kmean_k<<<dim3(8, 8), 128, 0, stream>>>(u, kmean);
        moba_k<<<dim3(S, 8), 256, 0, stream>>>(u, kmean, rel_bias, ga);
        mla_k<<<dim3(S, 8), 256, 0, stream>>>(qb, kvb, krope, u, gb);
        mem_k<<<dim3(S, 4), 256, 0, stream>>>(u, mkv, gm);
        gemm(ga, 1024, w_p_moba, 2048, pa, 2048, S, 2048, 1024, stream);
        gemm(gb, 1024, w_p_mla, 2048, pb, 2048, S, 2048, 1024, stream);
        gemm(gm, 512, w_p_mem, 2048, pm, 2048, S, 2048, 512, stream);
        merge_k<<<(S * 2048) / 256, 256, 0, stream>>>(u, pa, pb, pm, y);
        gemm(y, 2048, w_out, 2048, xo, 2048, S, 2048, 2048, stream);
        final_k<<<S, 256, 0, stream>>>(xb, xo, g_final, out + (size_t)b * S * D_MODEL);
    }
}
```

```cpp
#include <hip/hip_runtime.h>
#include <cstdio>
#include <cstdint>
#include <cmath>

#define LAS __attribute__((address_space(3)))
#define GAS __attribute__((address_space(1)))
typedef unsigned short bf16_t;
typedef short bf16x8 __attribute__((ext_vector_type(8)));
typedef short s16x4 __attribute__((ext_vector_type(4)));
typedef float f32x2 __attribute__((ext_vector_type(2)));
typedef float f32x4 __attribute__((ext_vector_type(4)));
typedef float f32x16 __attribute__((ext_vector_type(16)));
typedef unsigned u32x2 __attribute__((ext_vector_type(2)));
typedef unsigned u32x4 __attribute__((ext_vector_type(4)));

#ifndef MK_N_LAUNCHES
#define MK_N_LAUNCHES 7
#endif
constexpr int N_LAUNCHES = MK_N_LAUNCHES;
constexpr int N_PHASES = 7;

constexpr int D_MODEL = 2048, BATCH = 4, SEQ = 2048, NTOK = BATCH * SEQ, MEMT = 256;
constexpr int IN_WIDTH = 13120, NPAD = 13312;
constexpr float EPS = 1e-6f;
constexpr float LOG2E = 1.4426950408889634f;
constexpr float C2A = 0.08838834764831845f * LOG2E;
constexpr float C2B = 0.07216878364870322f * LOG2E;

constexpr size_t MiB = 1u << 20;
constexpr size_t WS_CTL = 0, CTL_ZERO_BYTES = 1 * MiB;
constexpr size_t WS_TAB = 1 * MiB;
constexpr size_t TAB_COS = 0, TAB_SIN = 262144, TAB_LUT = 524288, TAB_KMEAN = 524288 + 16384;
constexpr size_t WS_WINT = 2 * MiB;
constexpr size_t WS_WMEMT = 54 * MiB;
constexpr size_t WS_WUQT = 58 * MiB;
constexpr size_t WS_WUKVT = 60 * MiB;
constexpr size_t WS_WPT = 61 * MiB;
constexpr size_t WS_WOUTT = 71 * MiB;
constexpr size_t WS_H = 80 * MiB;
constexpr size_t WS_MB = 112 * MiB;
constexpr size_t WS_QA = 116 * MiB, WS_KA = 132 * MiB, WS_VA = 148 * MiB, WS_ZA = 164 * MiB;
constexpr size_t WS_CQ = 180 * MiB;
constexpr size_t WS_CKV = 188 * MiB;
constexpr size_t WS_ZB = 192 * MiB;
constexpr size_t WS_QM = 208 * MiB, WS_ZM = 216 * MiB;
constexpr size_t WS_GLA = 224 * MiB, WS_GLB = 256 * MiB, WS_GLM = 288 * MiB;
constexpr size_t WS_QB = 320 * MiB;
constexpr size_t WS_KB = 344 * MiB;
constexpr size_t WS_VB = 368 * MiB;
constexpr size_t WS_MKV = 384 * MiB;
constexpr size_t WS_G = WS_WINT;
constexpr size_t WS_Y = WS_H;
constexpr size_t WS_END = 386 * MiB;
constexpr int CW_BAR = 4096;
constexpr int CW_SSQP = 65536;

constexpr int RING_BYTES = 131072;
constexpr int LDSCTL_OFF = RING_BYTES, MISC_OFF = LDSCTL_OFF + 320;
constexpr int LDS_BYTES = 147456;
constexpr int NWAVES = 8;

__device__ const unsigned char T5_BUCKET[128] = {
    0, 1, 2, 3, 4, 5, 6, 7, 8, 9, 10, 11, 12, 13, 14, 15, 16, 16, 16, 17, 17, 18, 18, 18, 19, 19, 19, 20, 20, 20, 20, 21, 21, 21, 21, 22, 22, 22, 22, 22,
    23, 23, 23, 23, 23, 23, 24, 24, 24, 24, 24, 24, 25, 25, 25, 25, 25, 25, 25, 26, 26, 26, 26, 26, 26, 26, 26, 27, 27, 27, 27, 27, 27, 27, 27, 27, 27,
    28, 28, 28, 28, 28, 28, 28, 28, 28, 28, 29, 29, 29, 29, 29, 29, 29, 29, 29, 29, 29, 29, 30, 30, 30, 30, 30, 30, 30, 30, 30, 30, 30, 30, 30, 30,
    31, 31, 31, 31, 31, 31, 31, 31, 31, 31, 31, 31, 31, 31};
typedef __bf16 bf16x2_t __attribute__((ext_vector_type(2)));
__device__ __forceinline__ unsigned cvt_pk_bf16(float lo, float hi) { const f32x2 v = {lo, hi}; const bf16x2_t b = __builtin_convertvector(v, bf16x2_t); return __builtin_bit_cast(unsigned, b); }
__device__ __forceinline__ float bf2f(unsigned short b) { return __uint_as_float((unsigned)b << 16); }
__device__ __forceinline__ float bflo(unsigned w) { return __uint_as_float(w << 16); }
__device__ __forceinline__ float bfhi(unsigned w) { return __uint_as_float(w & 0xffff0000u); }
__device__ __forceinline__ float fast_sigmoid(float v) { return __builtin_amdgcn_rcpf(1.0f + __builtin_amdgcn_exp2f(-v * LOG2E)); }

namespace pg8 {
constexpr int BM = 256, BK = 64, HALF = 128, HTB = HALF * BK * 2, STAGE_BYTES = 8 * HTB, NXCD = 8, WGM = 8;
__host__ __device__ __forceinline__ int lds_byte(int r, int c) { const int st = (r >> 4) * 2 + (c >> 5), rr = r & 15, cc = c & 31, ob = rr * 64 + cc * 2; return st * 1024 + (ob ^ (((ob >> 9) & 1) << 5)); }
__host__ __device__ __forceinline__ void stage_rc(int b, int& R, int& C) { const int st = b / 1024, sb = b % 1024, swz = sb ^ (((sb >> 9) & 1) << 5); R = (st >> 1) * 16 + swz / 64; C = (st & 1) * 32 + (swz % 64) / 2; }
__host__ __device__ __forceinline__ int perm32(int rho) { const int n = rho >> 4, i = rho & 15; return 8 * (i >> 2) + 4 * n + (i & 3); }

struct Unit { int pm, pn; };
struct Gemm { const bf16_t* A; const bf16_t* Bt; int K, lda, ldb; };

struct StaticOrder {
    int nM, nN, nwg, G, c, extra, extra_pm0, extra_pn0, extra_nn;
    __device__ void init(int nM_, int nN_, int G_, int c_) { nM = nM_; nN = nN_; nwg = nM * nN; G = G_; c = c_; extra = 0; extra_pm0 = 0; extra_pn0 = 0; extra_nn = 1; }
    __device__ bool next(int i, Unit& u) const {
        const long L = (long)i * G + c;
        if (L >= nwg) { const int e = (int)(L - nwg); if (e >= extra) return false; u.pm = extra_pm0 + e / extra_nn; u.pn = extra_pn0 + e % extra_nn; return true; }
        int wgid = (int)L; { const int q = nwg / NXCD, r = nwg % NXCD, xcd = wgid % NXCD, off = wgid / NXCD; wgid = (xcd < r ? xcd * (q + 1) : r * (q + 1) + (xcd - r) * q) + off; }
        const int nig = WGM * nN, gid = wgid / nig, fm = gid * WGM, gsz = (nM - fm) < WGM ? (nM - fm) : WGM;
        u.pm = fm + ((wgid % nig) % gsz); u.pn = (wgid % nig) / gsz; return true;
    }
};

template <class Epi, class Sched>
__device__ __forceinline__ void gemm_phase(LAS unsigned char* lds, const Gemm g, const Sched& S, const Epi& E) {
    int tid = threadIdx.x; asm volatile("" : "+v"(tid));
    const int wid = __builtin_amdgcn_readfirstlane(tid >> 6), lane = tid & 63, wr = wid >> 2, wc = wid & 3, fr = lane & 15, fq = lane >> 4;
    const int nt = g.K / BK;
    unsigned voffA[2], voffB[2];
#pragma unroll
    for (int i = 0; i < 2; ++i) { int R, C; stage_rc(tid * 16 + i * 8192, R, C); const int Rb = (R & ~31) + perm32(R & 31);
        voffA[i] = (unsigned)(R * g.lda + C) * 2u; voffB[i] = (unsigned)(Rb * g.ldb + C) * 2u; }
    const size_t kstep = (size_t)(BK * 2);
    const size_t hstepA = (size_t)HALF * g.lda * 2, hstepB = (size_t)HALF * g.ldb * 2;
    const size_t tstepA = 2 * hstepA, tstepB = 2 * hstepB;
    const unsigned ldsw = (unsigned)wid * 1024u;
    const int aoff = lds_byte(wr * 64 + fr, fq * 8), boff = lds_byte(wc * 32 + fr, fq * 8);
#define PG8_SA(b, h) (((b) * 2 + (h)) * HTB)
#define PG8_SB(b, h) ((4 + (b) * 2 + (h)) * HTB)
#define PG8_STAGE(bufoff, gbase, voff) do { _Pragma("unroll") for (int _i = 0; _i < 2; ++_i) \
        __builtin_amdgcn_global_load_lds((const unsigned*)((const char*)(gbase) + (voff)[_i]), (LAS unsigned*)(lds + (bufoff) + ldsw + _i * 8192), 16, 0, 0); } while (0)
#define PG8_LDA(dst, b, h) do { _Pragma("unroll") for (int m = 0; m < 4; ++m) _Pragma("unroll") for (int k = 0; k < 2; ++k) dst[m][k] = *(const LAS bf16x8*)(lds + PG8_SA(b, h) + aoff + m * 2048 + k * 1024); } while (0)
#define PG8_LDB(dst, b, h) do { _Pragma("unroll") for (int n = 0; n < 2; ++n) _Pragma("unroll") for (int k = 0; k < 2; ++k) dst[n][k] = *(const LAS bf16x8*)(lds + PG8_SB(b, h) + boff + n * 2048 + k * 1024); } while (0)
#define PG8_MMA(ai, bj, At, Bt) do { __builtin_amdgcn_s_setprio(1); _Pragma("unroll") for (int m = 0; m < 4; ++m) _Pragma("unroll") for (int n = 0; n < 2; ++n) _Pragma("unroll") for (int k = 0; k < 2; ++k) \
        acc[ai][bj][m][n] = __builtin_amdgcn_mfma_f32_16x16x32_bf16(Bt[n][k], At[m][k], acc[ai][bj][m][n], 0, 0, 0); __builtin_amdgcn_s_setprio(0); } while (0)
#define PG8_WAIT_V(n) asm volatile("s_waitcnt vmcnt(" #n ")" ::: "memory")
#define PG8_WAIT_L(n) asm volatile("s_waitcnt lgkmcnt(" #n ")" ::: "memory")
#define PG8_BAR __builtin_amdgcn_s_barrier()
#define PG8_SCHED __builtin_amdgcn_sched_barrier(0)
    Unit cur, nxt; int ui = 0;
    if (!S.next(0, cur)) return;
    f32x4 acc[2][2][4][2];
#pragma unroll
    for (int a = 0; a < 2; ++a)
#pragma unroll
        for (int b = 0; b < 2; ++b)
#pragma unroll
            for (int m = 0; m < 4; ++m)
#pragma unroll
                for (int n = 0; n < 2; ++n) acc[a][b][m][n] = (f32x4){0.f, 0.f, 0.f, 0.f};
    bf16x8 At[4][2], B0[2][2], B1[2][2];
    const char* cA = (const char*)g.A + (size_t)cur.pm * tstepA; const char* cB = (const char*)g.Bt + (size_t)cur.pn * tstepB;
    PG8_STAGE(PG8_SB(0, 0), cB, voffB); PG8_STAGE(PG8_SB(0, 1), cB + hstepB, voffB); PG8_STAGE(PG8_SA(0, 0), cA, voffA); PG8_STAGE(PG8_SA(0, 1), cA + hstepA, voffA);
    if (wr == 1) PG8_BAR;
    PG8_WAIT_V(2); PG8_BAR;
    PG8_STAGE(PG8_SB(1, 0), cB + kstep, voffB); PG8_STAGE(PG8_SA(1, 0), cA + kstep, voffA); PG8_STAGE(PG8_SB(1, 1), cB + hstepB + kstep, voffB);
    PG8_WAIT_V(6); PG8_BAR;
    for (;;) {
        const bool has_next = S.next(ui + 1, nxt);
        const char* nA = has_next ? (const char*)g.A + (size_t)nxt.pm * tstepA : cA; const char* nB = has_next ? (const char*)g.Bt + (size_t)nxt.pn * tstepB : cB;
        for (int t = 0; t < nt; t += 2) {
            const bool last = (t == nt - 2);
            const char* a1 = cA + (size_t)(t + 1) * kstep;
            const char* a2 = last ? nA : cA + (size_t)(t + 2) * kstep; const char* b2 = last ? nB : cB + (size_t)(t + 2) * kstep;
            const char* a3 = a2 + kstep; const char* b3 = b2 + kstep;
            PG8_LDB(B0, 0, 0); PG8_LDB(B1, 0, 1); PG8_SCHED; PG8_LDA(At, 0, 0); PG8_STAGE(PG8_SA(1, 1), a1 + hstepA, voffA);
            PG8_WAIT_V(8); PG8_WAIT_L(0); PG8_BAR; PG8_MMA(0, 0, At, B0); PG8_MMA(0, 1, At, B1); PG8_BAR; PG8_SCHED;
            PG8_LDA(At, 0, 1); PG8_STAGE(PG8_SB(0, 0), b2, voffB); PG8_STAGE(PG8_SB(0, 1), b2 + hstepB, voffB); PG8_STAGE(PG8_SA(0, 0), a2, voffA);
            PG8_WAIT_V(8); PG8_WAIT_L(0); PG8_BAR; PG8_MMA(1, 0, At, B0); PG8_MMA(1, 1, At, B1); PG8_BAR; PG8_SCHED;
            PG8_LDB(B0, 1, 0); PG8_LDB(B1, 1, 1); PG8_SCHED; PG8_LDA(At, 1, 0); PG8_STAGE(PG8_SA(0, 1), a2 + hstepA, voffA);
            PG8_WAIT_V(8); PG8_WAIT_L(0); PG8_BAR; PG8_MMA(0, 0, At, B0); PG8_MMA(0, 1, At, B1); PG8_BAR; PG8_SCHED;
            PG8_LDA(At, 1, 1); PG8_STAGE(PG8_SB(1, 0), b3, voffB); PG8_STAGE(PG8_SB(1, 1), b3 + hstepB, voffB); PG8_STAGE(PG8_SA(1, 0), a3, voffA);
            PG8_WAIT_V(8); PG8_WAIT_L(0); PG8_BAR; PG8_MMA(1, 0, At, B0); PG8_MMA(1, 1, At, B1); PG8_BAR; PG8_SCHED;
        }
        if (wr == 0) PG8_BAR;
        E(acc, cur, ui, wr, wc, fr, fq);
        if (!has_next) break;
#pragma unroll
        for (int a = 0; a < 2; ++a)
#pragma unroll
            for (int b = 0; b < 2; ++b)
#pragma unroll
                for (int m = 0; m < 4; ++m)
#pragma unroll
                    for (int n = 0; n < 2; ++n) acc[a][b][m][n] = (f32x4){0.f, 0.f, 0.f, 0.f};
        cur = nxt; cA = nA; cB = nB; ++ui;
        if (wr == 1) PG8_BAR;
    }
    PG8_WAIT_V(0);
    PG8_BAR;
#undef PG8_SA
#undef PG8_SB
#undef PG8_STAGE
#undef PG8_LDA
#undef PG8_LDB
#undef PG8_MMA
#undef PG8_WAIT_V
#undef PG8_WAIT_L
#undef PG8_BAR
#undef PG8_SCHED
}

template <int MODE>
__device__ __forceinline__ void store_tile(const f32x4 (&acc)[2][2][4][2], bf16_t* base  , int ldc, int rowbase,
                                           int wr, int wc, int fr, int fq, float scale, float* ssq) {
    const int row0 = rowbase + wr * 64 + fr, col0 = wc * 32 + 8 * fq;
#pragma unroll
    for (int ai = 0; ai < 2; ++ai)
#pragma unroll
        for (int m = 0; m < 4; ++m) {
            const int row = row0 + ai * HALF + m * 16;
            bf16_t* rowp = base + (size_t)row * ldc + col0; float sq = 0.f;
#pragma unroll
            for (int bj = 0; bj < 2; ++bj) {
                f32x4 v0 = acc[ai][bj][m][0], v1 = acc[ai][bj][m][1];
                if (MODE == 0) { v0 = v0 * scale; v1 = v1 * scale; }
                if (MODE == 1) {
#pragma unroll
                    for (int e = 0; e < 4; ++e) { v0[e] = v0[e] * fast_sigmoid(v0[e]); v1[e] = v1[e] * fast_sigmoid(v1[e]); } }
                if (MODE == 2) {
#pragma unroll
                    for (int e = 0; e < 4; ++e) { v0[e] = fast_sigmoid(v0[e]); v1[e] = fast_sigmoid(v1[e]); } }
                if (MODE == 3) {
#pragma unroll
                    for (int e = 0; e < 4; ++e) sq += v0[e] * v0[e] + v1[e] * v1[e]; }
                u32x4 w; w.x = cvt_pk_bf16(v0[0], v0[1]); w.y = cvt_pk_bf16(v0[2], v0[3]); w.z = cvt_pk_bf16(v1[0], v1[1]); w.w = cvt_pk_bf16(v1[2], v1[3]);
                *(u32x4*)(rowp + bj * HALF) = w;
            }
            if (MODE == 3) { sq += __shfl_xor(sq, 16); sq += __shfl_xor(sq, 32); if (fq == 0) ssq[(size_t)row * 16 + wc] = sq; }
        }
}
}

namespace att {
constexpr int NW = 8, QBLK = 32, KVBLK = 64, QB = NW * QBLK;
constexpr int SHM_V = KVBLK * 128 * 2, SHM_K = KVBLK * 192 * 2;
constexpr int OFF_V = 0, OFF_K = 2 * SHM_V, OFF_WS = OFF_K + 2 * SHM_K, OFF_KM = OFF_WS + NW * 64 * 4, OFF_LUT = OFF_KM + 8 * 128 * 4, OFF_OST = OFF_LUT + 320 * 4 + 256, LDS_BYTES = OFF_OST + NW * 4096;
static_assert(LDS_BYTES <= 131072 && OFF_OST % 16 == 0, "attention LDS map");
constexpr int LDO = 2560;
constexpr float THR2 = 11.0f;
#define SBAR() __builtin_amdgcn_sched_barrier(0)
__device__ __forceinline__ int v_st(int k, int c) { const int kk = (k & ~0xC) | ((k & 4) << 1) | ((k & 8) >> 1); return ((kk >> 3) * 4 + (c >> 5)) * 512 + ((kk & 7) * 32 + (c & 31)) * 2; }
__device__ __forceinline__ int v_rd_base(int lane) { return ((lane & 3) << 3) | (((lane >> 2) & 3) << 6) | (((lane >> 4) & 1) << 5) | (((lane >> 5) & 1) << 8); }
constexpr int v_rd_off(int d0, int ks, int half) { return d0 * 512 + ks * 4096 + half * 2048; }
__device__ __forceinline__ int crow(int r, int hi) { return (r & 3) + 8 * (r >> 2) + 4 * hi; }
__device__ __forceinline__ bf16x8 load8(const bf16_t* p) { return *reinterpret_cast<const bf16x8*>(p); }

struct BlockRef { const bf16_t* Q; const bf16_t* K; const bf16_t* V; const bf16_t* Z; bf16_t* O; int ldq, ldk, ldv, ldz; int P0; int nt; const float* kmean; const float* lut; };
template <int DK> struct Seam { bf16x8 qr[8]; bf16x8 st_v0, st_v1, st_k0, st_k1, st_k2; };

__device__ __forceinline__ void mask_causal(f32x16& p0, f32x16& p1, int dq) {
    const float NEG = -__builtin_inff();
#pragma unroll
    for (int r = 0; r < 16; ++r) { const int c = (r & 3) + 8 * (r >> 2); if (dq - c < 0) p0[r] = NEG; if (dq - c - 32 < 0) p1[r] = NEG; }
}
__device__ __forceinline__ void lut_add(f32x16& p0, f32x16& p1, int dq, const LAS float* lut) {
    const LAS float* b = lut + (dq + 96 - 63);
#pragma unroll
    for (int r = 0; r < 16; ++r) { const int c = (r & 3) + 8 * (r >> 2); p0[r] += b[63 - c]; p1[r] += b[31 - c]; }
}
__device__ __forceinline__ void partialSM(f32x16& p0, f32x16& p1, float& m_reg, float& mn, float& alpha) {
    float pmax = p0[0];
#pragma unroll
    for (int r = 1; r < 16; ++r) pmax = fmaxf(pmax, p0[r]);
#pragma unroll
    for (int r = 0; r < 16; ++r) pmax = fmaxf(pmax, p1[r]);
    { auto rr = __builtin_amdgcn_permlane32_swap(__float_as_uint(pmax), __float_as_uint(pmax), false, false);
      pmax = fmaxf(__uint_as_float(rr[0]), __uint_as_float(rr[1])); }
    if (__builtin_expect(__all((pmax - m_reg) <= THR2), 1)) { mn = m_reg; alpha = 1.f; }
    else { mn = fmaxf(m_reg, pmax); alpha = __builtin_amdgcn_exp2f(m_reg - mn); m_reg = mn; }
#pragma unroll
    for (int r = 0; r < 16; ++r) p0[r] = p0[r] - mn;
#pragma unroll
    for (int r = 0; r < 16; ++r) p1[r] = p1[r] - mn;
#pragma unroll
    for (int r = 0; r < 16; ++r) p0[r] = __builtin_amdgcn_exp2f(p0[r]);
}
__device__ __forceinline__ void finishSM(f32x16& p0, f32x16& p1, float alpha, float& l_reg, bf16x8& pa0, bf16x8& pa1, bf16x8& pa2, bf16x8& pa3) {
#pragma unroll
    for (int r = 0; r < 16; ++r) p1[r] = __builtin_amdgcn_exp2f(p1[r]);
    float ps = 0;
#pragma unroll
    for (int r = 0; r < 16; ++r) ps += p0[r];
#pragma unroll
    for (int r = 0; r < 16; ++r) ps += p1[r];
    { auto rr = __builtin_amdgcn_permlane32_swap(__float_as_uint(ps), __float_as_uint(ps), false, false);
      ps = __uint_as_float(rr[0]) + __uint_as_float(rr[1]); }
    l_reg = l_reg * alpha + ps;
#define PK4(P, B_, OUT) do { unsigned a0 = cvt_pk_bf16(P[B_+0], P[B_+1]), a1 = cvt_pk_bf16(P[B_+2], P[B_+3]);                          \
        unsigned b0 = cvt_pk_bf16(P[B_+4], P[B_+5]), b1 = cvt_pk_bf16(P[B_+6], P[B_+7]);                                             \
        auto r0 = __builtin_amdgcn_permlane32_swap(a0, b0, false, false); auto r1 = __builtin_amdgcn_permlane32_swap(a1, b1, false, false); \
        u32x4 w = {r0[0], r1[0], r0[1], r1[1]}; OUT = *reinterpret_cast<bf16x8*>(&w); } while (0)
    PK4(p0, 0, pa0); PK4(p0, 8, pa1); PK4(p1, 0, pa2); PK4(p1, 8, pa3);
#undef PK4
}
template <int DK, int KB>
__device__ __forceinline__ void qkt(f32x16& p0, f32x16& p1, const char* K_lds, int r32, int hi, const bf16x8* qr, const char* qrl, float cinit) {
#pragma unroll
    for (int r = 0; r < 16; ++r) { p0[r] = cinit; p1[r] = cinit; }
    const char* kb[4];
#pragma unroll
    for (int dd = 0; dd < 4; ++dd) kb[dd] = K_lds + KB * SHM_K + r32 * (DK * 2) + (((dd * 16 + hi * 8) * 2) ^ ((r32 & 7) << 4));
    const int t16 = (hi ^ (r32 & 7)) << 4;
#pragma unroll
    for (int d0 = 0; d0 < DK / 16; ++d0) { const char* a = kb[d0 & 3] + (d0 >> 2) * 128;
        bf16x8 b0 = *reinterpret_cast<const bf16x8*>(a);
        bf16x8 b1 = *reinterpret_cast<const bf16x8*>(a + 32 * DK * 2);
        bf16x8 qf; if (d0 < 8) qf = qr[d0 < 8 ? d0 : 0]; else qf = *reinterpret_cast<const bf16x8*>(qrl + ((((d0 - 8) & 3) * 32) ^ t16));
        p0 = __builtin_amdgcn_mfma_f32_32x32x16_bf16(b0, qf, p0, 0, 0, 0);
        p1 = __builtin_amdgcn_mfma_f32_32x32x16_bf16(b1, qf, p1, 0, 0, 0); }
}
template <int VB>
__device__ __forceinline__ void pv_tile(f32x16* o, int vb0, bf16x8 pa0, bf16x8 pa1, bf16x8 pa2, bf16x8 pa3) {
#define TRRD(dst, off) asm volatile("ds_read_b64_tr_b16 %0, %1 offset:%2" : "=&v"(dst) : "v"(vb0), "i"(off) : "memory")
#define PV_D0(d0) do { s16x4 l0, l1, l2, l3, h0, h1, h2, h3; constexpr int b_ = VB * SHM_V + v_rd_off(d0, 0, 0); \
        TRRD(l0, b_); TRRD(h0, b_ + 2048); TRRD(l1, b_ + 4096); TRRD(h1, b_ + 6144); TRRD(l2, b_ + 8192); TRRD(h2, b_ + 10240); TRRD(l3, b_ + 12288); TRRD(h3, b_ + 14336); \
        asm volatile("s_waitcnt lgkmcnt(0)" ::: "memory"); SBAR();   \
        o[d0] = __builtin_amdgcn_mfma_f32_32x32x16_bf16(pa0, (bf16x8){l0[0], l0[1], l0[2], l0[3], h0[0], h0[1], h0[2], h0[3]}, o[d0], 0, 0, 0);   \
        o[d0] = __builtin_amdgcn_mfma_f32_32x32x16_bf16(pa1, (bf16x8){l1[0], l1[1], l1[2], l1[3], h1[0], h1[1], h1[2], h1[3]}, o[d0], 0, 0, 0);   \
        o[d0] = __builtin_amdgcn_mfma_f32_32x32x16_bf16(pa2, (bf16x8){l2[0], l2[1], l2[2], l2[3], h2[0], h2[1], h2[2], h2[3]}, o[d0], 0, 0, 0);   \
        o[d0] = __builtin_amdgcn_mfma_f32_32x32x16_bf16(pa3, (bf16x8){l3[0], l3[1], l3[2], l3[3], h3[0], h3[1], h3[2], h3[3]}, o[d0], 0, 0, 0); } while (0)
    PV_D0(0); PV_D0(1); PV_D0(2); PV_D0(3);
#undef PV_D0
#undef TRRD
}

#define A_VMW() asm volatile("s_waitcnt vmcnt(0)" ::: "memory")
#define A_VMWN(n) asm volatile("s_waitcnt vmcnt(%0)" :: "i"(n) : "memory")
#define A_SLOAD(Kp, ldk_, Vp, ldv_, k0) do { const char* kb_ = (const char*)(Kp) + (size_t)(k0) * (size_t)(ldk_) * 2; const char* vb_ = (const char*)(Vp) + (size_t)(k0) * (size_t)(ldv_) * 2; \
        const unsigned vk_ = (unsigned)(sr * (ldk_) + sc) * 2u, vv_ = (unsigned)(sr * (ldv_) + sc) * 2u; \
        S.st_v0 = *(const bf16x8*)(vb_ + vv_); S.st_v1 = *(const bf16x8*)(vb_ + (size_t)(32 * (ldv_) * 2) + vv_); \
        S.st_k0 = *(const bf16x8*)(kb_ + vk_); S.st_k1 = *(const bf16x8*)(kb_ + (size_t)(32 * (ldk_) * 2) + vk_); \
        if (DK == 192) S.st_k2 = *(const bf16x8*)(kb_ + (unsigned)((tid >> 3) * (ldk_) + 128 + (tid & 7) * 8) * 2u); } while (0)
#define A_SWRITE_K(bf) do { *(bf16x8*)(K_lds + (bf) * SHM_K + kws) = S.st_k0; *(bf16x8*)(K_lds + (bf) * SHM_K + kws + 32 * DK * 2) = S.st_k1; \
        if (DK == 192) *(bf16x8*)(K_lds + (bf) * SHM_K + kws2) = S.st_k2; } while (0)
#define A_SWRITE_V(bf) do { *(bf16x8*)(V_lds + (bf) * SHM_V + vst0) = S.st_v0; *(bf16x8*)(V_lds + (bf) * SHM_V + vst1) = S.st_v1; } while (0)

#define A_QROPE_DMA(Qp, ldq_) do { if (DK == 192) { _Pragma("unroll") for (int i_ = 0; i_ < 4; ++i_) { const int p_ = i_ * 64 + lane, row_ = p_ >> 3, slot_ = p_ & 7; \
        const bf16_t* src_ = (Qp) + (size_t)(wid * QBLK + row_) * (ldq_) + 128 + ((slot_ ^ (row_ & 7)) * 8); \
        __builtin_amdgcn_global_load_lds((const unsigned*)src_, (LAS unsigned*)((LAS unsigned char*)lds + OFF_OST + wid * 4096 + i_ * 1024), 16, 0, 0); } } } while (0)
template <int DK>
__device__ __forceinline__ void attn_prime(const BlockRef& cur, char* lds, Seam<DK>& S) {
    int tid = threadIdx.x; asm volatile("" : "+v"(tid));
    const int wid = __builtin_amdgcn_readfirstlane(tid >> 6), lane = tid & 63, r32 = lane & 31, hi = lane >> 5;
    const int sr = tid >> 4, sc = (tid & 15) * 8, kws = sr * (DK * 2) + ((sc * 2) ^ ((sr & 7) << 4));
    const int kws2 = (tid >> 3) * (DK * 2) + ((256 + (tid & 7) * 16) ^ (((tid >> 3) & 7) << 4));
    char* K_lds = lds + OFF_K;
    A_QROPE_DMA(cur.Q, cur.ldq);
#pragma unroll
    for (int d0 = 0; d0 < 8; ++d0) S.qr[d0] = load8(cur.Q + (size_t)(wid * QBLK + r32) * cur.ldq + d0 * 16 + hi * 8);
    A_SLOAD(cur.K, cur.ldk, cur.V, cur.ldv, 0); A_VMW(); A_SWRITE_K(0);
    __syncthreads();
}

template <int DK, int MODE>
__device__ __forceinline__ void attn_block(const BlockRef& cur, const BlockRef& nxt, char* lds, Seam<DK>& S) {
    int tid = threadIdx.x; asm volatile("" : "+v"(tid));
    const int wid = __builtin_amdgcn_readfirstlane(tid >> 6), lane = tid & 63, r32 = lane & 31, hi = lane >> 5;
    const char* qrl = lds + OFF_OST + wid * 4096 + r32 * 128;
    const int NT = cur.nt;
    const int qlo = cur.P0 + wid * QBLK, qm = qlo + r32 - 4 * hi;
    char* V_lds = lds + OFF_V; char* K_lds = lds + OFF_K;
    float* ws = (float*)(lds + OFF_WS) + wid * 64; float* li_l = ws; float* al_l = ws + 32;
    float m_reg = -1e30f, l_reg = 0; f32x16 o[4] = {};
    const int sr = tid >> 4, sc = (tid & 15) * 8, vst0 = v_st(sr, sc), vst1 = v_st(32 + sr, sc), kws = sr * (DK * 2) + ((sc * 2) ^ ((sr & 7) << 4));
    const int kws2 = (tid >> 3) * (DK * 2) + ((256 + (tid & 7) * 16) ^ (((tid >> 3) & 7) << 4));
    const int vb0 = (int)(uintptr_t)V_lds + v_rd_base(lane);
    const bf16_t* Kh = cur.K; const bf16_t* Vh = cur.V; const int ldk = cur.ldk, ldv = cur.ldv;
    const LAS float* lutl = (const LAS float*)(lds + OFF_LUT);
    unsigned selmask = 0; float b31 = 0.f; const int own = cur.P0 >> 8;
    if (MODE == 0) {
        LAS float* kml = (LAS float*)(lds + OFF_KM); LAS float* lw = (LAS float*)(lds + OFF_LUT);
        kml[tid] = cur.kmean[tid]; kml[tid + 512] = cur.kmean[tid + 512];
        if (tid < 320) lw[tid] = cur.lut[tid];
        __syncthreads();
        b31 = lutl[96 + 128];
        float g[7];
#pragma unroll
        for (int n = 0; n < 7; ++n) g[n] = -__builtin_inff();
#pragma unroll
        for (int n = 0; n < 7; ++n) if (n < own) {
            float a = 0.f;
#pragma unroll
            for (int d0 = 0; d0 < 8; ++d0) { const LAS float* km = kml + n * 128 + d0 * 16 + hi * 8;
                const f32x4 k0 = *(const LAS f32x4*)km, k1 = *(const LAS f32x4*)(km + 4); const bf16x8 q = S.qr[d0];
                a += bf2f((unsigned short)q[0]) * k0[0] + bf2f((unsigned short)q[1]) * k0[1] + bf2f((unsigned short)q[2]) * k0[2] + bf2f((unsigned short)q[3]) * k0[3]
                   + bf2f((unsigned short)q[4]) * k1[0] + bf2f((unsigned short)q[5]) * k1[1] + bf2f((unsigned short)q[6]) * k1[2] + bf2f((unsigned short)q[7]) * k1[3]; }
            a += __shfl_xor(a, 32);
            g[n] = a;
        }
#pragma unroll
        for (int j = 0; j < 3; ++j) {
            float bv = -__builtin_inff(); int best = -1;
#pragma unroll
            for (int n = 0; n < 7; ++n) { const bool free_ = !((selmask >> n) & 1u); if (free_ && g[n] > bv) { bv = g[n]; best = n; } }
            if (best >= 0) selmask |= 1u << best;
        }
    }
#define RESC(a) do { if (__any((a) < 1.f)) { if (hi == 0) al_l[r32] = (a); asm volatile("s_waitcnt lgkmcnt(0)" ::: "memory");              \
                     _Pragma("unroll") for (int d_ = 0; d_ < 4; ++d_) _Pragma("unroll") for (int r = 0; r < 16; ++r) o[d_][r] *= al_l[crow(r, hi)]; } } while (0)
#define KBASE(t) ((t) * KVBLK)
#define CINIT(t) ((MODE == 0) ? (((((t) >> 2) < own) && !((selmask >> ((t) >> 2)) & 1u)) ? -__builtin_inff() : ((KBASE(t) + 63 + 128 <= qlo) ? b31 : 0.f)) : 0.f)
#define MASKT(P0_, P1_, t) do { const int kb_ = KBASE(t); \
        if (MODE == 0) { if (!(kb_ + 63 + 128 <= qlo)) { lut_add(P0_, P1_, qm - kb_, lutl); if (kb_ + KVBLK - 1 > qlo) mask_causal(P0_, P1_, qm - kb_); } } \
        if (MODE == 1) { if (kb_ + KVBLK - 1 > qlo) mask_causal(P0_, P1_, qm - kb_); } } while (0)
    constexpr int NQL = 8;
#define SEAM_K0() do { A_VMWN(NQL); A_SWRITE_K(0); SBAR(); } while (0)
    f32x16 pA0, pA1, pB0, pB1; float mnA, mnB, alA, alB; bf16x8 pa0, pa1, pa2, pa3;
    A_SWRITE_V(0); SBAR();
    if (NT > 1) { A_SLOAD(Kh, ldk, Vh, ldv, KBASE(1)); }
    SBAR(); qkt<DK, 0>(pA0, pA1, K_lds, r32, hi, S.qr, qrl, CINIT(0));
    MASKT(pA0, pA1, 0); partialSM(pA0, pA1, m_reg, mnA, alA);
    if (NT > 1) { A_VMW(); A_SWRITE_V(1); A_SWRITE_K(1); }
    __syncthreads();
#define HALF_STEP(PX0, PX1, mnX, alX, PY0, PY1, alY, t, KB, VB, SB) do {                                                      \
        SBAR(); qkt<DK, KB>(PX0, PX1, K_lds, r32, hi, S.qr, qrl, CINIT(t));                                             \
        finishSM(PY0, PY1, alY, l_reg, pa0, pa1, pa2, pa3); SBAR();                                                           \
        if ((t) + 1 < NT) { A_SLOAD(Kh, ldk, Vh, ldv, KBASE((t) + 1)); SBAR(); }                                               \
        pv_tile<VB>(o, vb0, pa0, pa1, pa2, pa3); MASKT(PX0, PX1, (t)); partialSM(PX0, PX1, m_reg, mnX, alX);                                        \
        __syncthreads();                                                                                                      \
        if ((t) + 1 < NT) { A_VMW(); A_SWRITE_V(SB); A_SWRITE_K(SB); }                                                                          \
        RESC(alX); __syncthreads(); } while (0)
    for (int t = 1; t + 1 < NT; t += 2) {
        HALF_STEP(pB0, pB1, mnB, alB, pA0, pA1, alA, t, 1, 0, 0);
        HALF_STEP(pA0, pA1, mnA, alA, pB0, pB1, alB, t + 1, 0, 1, 1);
    }
    const bool even = (NT & 1) == 0;
    if (even) { SBAR(); qkt<DK, 1>(pB0, pB1, K_lds, r32, hi, S.qr, qrl, CINIT(NT - 1)); SBAR(); }
    A_SLOAD(nxt.K, nxt.ldk, nxt.V, nxt.ldv, 0); SBAR();
#pragma unroll
    for (int d0 = 0; d0 < 8; ++d0) S.qr[d0] = load8(nxt.Q + (size_t)(wid * QBLK + r32) * nxt.ldq + d0 * 16 + hi * 8);
    SBAR();
    finishSM(pA0, pA1, alA, l_reg, pa0, pa1, pa2, pa3); SBAR();
    pv_tile<0>(o, vb0, pa0, pa1, pa2, pa3);
    if (even) { MASKT(pB0, pB1, NT - 1); partialSM(pB0, pB1, m_reg, mnB, alB); __syncthreads(); RESC(alB);
        finishSM(pB0, pB1, alB, l_reg, pa0, pa1, pa2, pa3); SBAR(); pv_tile<1>(o, vb0, pa0, pa1, pa2, pa3); }
    SBAR(); SEAM_K0();
    if (hi == 0) li_l[r32] = l_reg; asm volatile("s_waitcnt lgkmcnt(0)" ::: "memory");
    {
        bf16_t* stg = (bf16_t*)(lds + OFF_OST) + wid * 2048;
        char* Owb = (char*)(cur.O + (size_t)(wid * QBLK) * LDO); const char* Zwb = (const char*)(cur.Z + (size_t)(wid * QBLK) * cur.ldz);
        int lrow = lane >> 4; const int ch = lane & 15; asm volatile("" : "+v"(lrow));
        const unsigned obase = (unsigned)(lrow * LDO + ch * 8) * 2u, zbase = (unsigned)(lrow * cur.ldz + ch * 8) * 2u, zstep = (unsigned)cur.ldz * 8u;
#pragma unroll
        for (int ps = 0; ps < 2; ++ps) {
#pragma unroll
            for (int r8 = 0; r8 < 8; ++r8) { const int r = ps * 8 + r8; const int srow = (r8 & 3) + 8 * (r8 >> 2) + 4 * hi;
                const float rl = __builtin_amdgcn_rcpf(li_l[crow(r, hi)]);
#pragma unroll
                for (int d0 = 0; d0 < 4; ++d0) { const float v = o[d0][r] * rl; const float vn = __shfl_xor(v, 1);
                    if ((r32 & 1) == 0) *(unsigned*)(stg + srow * 128 + d0 * 32 + r32) = cvt_pk_bf16(v, vn); } }
            asm volatile("s_waitcnt lgkmcnt(0)" ::: "memory");
#pragma unroll
            for (int i = 0; i < 4; ++i) {
                const u32x4 ov = *(const u32x4*)(stg + (i * 4 + lrow) * 128 + ch * 8);
                const u32x4 zv = *(const u32x4*)(Zwb + zbase + (unsigned)(ps * 4 + i) * zstep);
                u32x4 w; w.x = cvt_pk_bf16(bflo(ov.x) * bflo(zv.x), bfhi(ov.x) * bfhi(zv.x)); w.y = cvt_pk_bf16(bflo(ov.y) * bflo(zv.y), bfhi(ov.y) * bfhi(zv.y));
                w.z = cvt_pk_bf16(bflo(ov.z) * bflo(zv.z), bfhi(ov.z) * bfhi(zv.z)); w.w = cvt_pk_bf16(bflo(ov.w) * bflo(zv.w), bfhi(ov.w) * bfhi(zv.w));
                *(u32x4*)(Owb + obase + (unsigned)((ps * 16 + i * 4) * LDO * 2)) = w; }
            asm volatile("s_waitcnt lgkmcnt(0)" ::: "memory");
        }
    }
    if (DK == 192) { A_QROPE_DMA(nxt.Q, nxt.ldq); A_VMW(); }
    __syncthreads();
#undef RESC
#undef KBASE
#undef CINIT
#undef MASKT
#undef SEAM_K0
#undef HALF_STEP
}
#undef A_VMW
#undef A_VMWN
#undef A_SLOAD
#undef A_SWRITE_K
#undef A_SWRITE_V
#undef A_QROPE_DMA
#undef SBAR
}

typedef GAS unsigned gu32;
#define RLX_AGENT __ATOMIC_RELAXED, __HIP_MEMORY_SCOPE_AGENT
#define LDS_WAIT() asm volatile("s_waitcnt lgkmcnt(0)" ::: "memory")
#define VM_WAIT() asm volatile("s_waitcnt vmcnt(0)" ::: "memory")
#define XB_TMO      128
#define XB_XCNT(j)  (256  + 64 * (j))
#define XB_XSUB(j)  (1280 + 64 * (j))
#define XB_XGEN(j)  (2304 + 64 * (j))
#define XB_TOP      3328
#define XB_TOPGEN   3392
#define XCD_BAR_WORDS 3456
#define XB_SPIN_CAP (1u << 18)
__device__ __forceinline__ unsigned xb_ld(unsigned* p)              { return __hip_atomic_load(p, __ATOMIC_RELAXED, __HIP_MEMORY_SCOPE_AGENT); }
__device__ __forceinline__ unsigned xb_add(unsigned* p, unsigned v) { return __hip_atomic_fetch_add(p, v, __ATOMIC_RELAXED, __HIP_MEMORY_SCOPE_AGENT); }
__device__ __forceinline__ unsigned xb_xcc_id() { return (unsigned)__builtin_amdgcn_s_getreg((3 << 11) | 20) & 0xFu; }
#define XB_SPIN(cond, bar) do { unsigned _sp = 0; while (cond) { __builtin_amdgcn_s_sleep(1); \
    if ((++_sp & 255u) == 0u) { if (xb_ld(&(bar)[XB_TMO])) break; if (_sp > XB_SPIN_CAP) { atomicAdd(&(bar)[XB_TMO], 1u); break; } } } } while (0)
struct XcdBarrier { unsigned* bar; unsigned x; volatile LAS unsigned* st; };
__device__ __forceinline__ XcdBarrier xcd_barrier_post(unsigned* bar, volatile LAS unsigned* st) {
    XcdBarrier b; b.bar = bar; b.x = xb_xcc_id(); b.st = st;
    if (threadIdx.x == 0) (void)xb_add(&bar[XB_XCNT(b.x)], 1u);
    return b;
}
__device__ __forceinline__ void xcd_barrier_complete(unsigned* bar, unsigned x, unsigned& nloc, unsigned& nx) {
    const unsigned G = gridDim.x * gridDim.y * gridDim.z;
    unsigned sum, cnt, mine, sp = 0u;
    for (;;) {
        sum = 0u; cnt = 0u; mine = 0u;
#pragma unroll
        for (unsigned j = 0; j < 16; ++j) { const unsigned c = xb_ld(&bar[XB_XCNT(j)]); sum += c; cnt += (c > 0u) ? 1u : 0u; mine = (j == x) ? c : mine; }
        if (sum == G) break;
        __builtin_amdgcn_s_sleep(1);
        if ((++sp & 255u) == 0u) { if (xb_ld(&bar[XB_TMO])) break; if (sp > XB_SPIN_CAP) { atomicAdd(&bar[XB_TMO], 1u); break; } }
    }
    nloc = mine > 0u ? mine : 1u; nx = cnt > 0u ? cnt : 1u;
}
__device__ __forceinline__ void xcd_barrier(const XcdBarrier& b) {
    asm volatile("s_waitcnt vmcnt(0)" ::: "memory");
    __syncthreads();
    if (threadIdx.x == 0) {
        unsigned* bar = b.bar;
        __builtin_amdgcn_s_waitcnt(0);
        unsigned nloc = b.st[0], nx = b.st[1];
        if (nloc == 0u) { xcd_barrier_complete(bar, b.x, nloc, nx); b.st[0] = nloc; b.st[1] = nx; }
        const unsigned old = xb_add(&bar[XB_XSUB(b.x)], 1u);
        const unsigned gen = old / nloc;
        if (old + 1u == (gen + 1u) * nloc) {
            __builtin_amdgcn_fence(__ATOMIC_RELEASE, "agent");
            asm volatile("s_waitcnt vmcnt(0)" ::: "memory");
            const unsigned og = xb_add(&bar[XB_TOP], 1u);
            const unsigned tg = og / nx;
            if (og + 1u == (tg + 1u) * nx) xb_add(&bar[XB_TOPGEN], 1u);
            else XB_SPIN(xb_ld(&bar[XB_TOPGEN]) == tg, bar);
            __builtin_amdgcn_fence(__ATOMIC_ACQUIRE, "agent");
            xb_add(&bar[XB_XGEN(b.x)], 1u);
            asm volatile("s_waitcnt vmcnt(0)" ::: "memory");
        } else {
            XB_SPIN(xb_ld(&bar[XB_XGEN(b.x)]) == gen, bar);
            __builtin_amdgcn_fence(__ATOMIC_ACQUIRE, "agent");
            asm volatile("s_waitcnt vmcnt(0)" ::: "memory");
        }
    }
    __syncthreads();
}

struct Args {
    const float* x; const float* mem; const float* g_norm; const float* w_in; const float* g_cq; const float* w_uq; const float* g_ckv; const float* w_ukv;
    const float* g_mem; const float* w_mem_kv; const float* rel_bias; const float* w_p_moba; const float* w_p_mla; const float* w_p_mem; const float* w_out; const float* g_final;
    float* out; unsigned char* ws; int ph_lo, ph_hi;
};

__device__ __forceinline__ float wave_sum(float v) {
#pragma unroll
    for (int o = 1; o < 64; o <<= 1) v += __shfl_xor(v, o);
    return v;
}
__host__ __device__ __forceinline__ int rope_perm(int j) { return j < 32 ? 8 * (j >> 2) + (j & 3) : 8 * ((j - 32) >> 2) + 4 + ((j - 32) & 3); }
template <int MAP> __device__ __forceinline__ int row_map(int n) {
    if (MAP == 1) { if (n < 4864) return n; if (n < 4928) return 4864 + rope_perm(n - 4864); return n + 192; }
    if (MAP == 2) { const int h = n / 192, j = n - h * 192; return j < 128 ? h * 128 + j : 1024 + h * 64 + rope_perm(j - 128); }
    return n;
}
template <int MAP>
__device__ __forceinline__ void p0_transpose_item(const float* W, int N, bf16_t* WT, int ldt, int koff, const float* g, LAS float* scr, int item, int lane) {
    const int nblk = N / 32, kb = item / nblk, nb = item % nblk, k0 = 64 * kb, n0 = 32 * nb;
#pragma unroll 8
    for (int i = 0; i < 32; ++i) { const int kk = 2 * i + (lane >> 5); float v = W[(size_t)(k0 + kk) * N + n0 + (lane & 31)]; if (g) v *= g[k0 + kk]; scr[kk * 33 + (lane & 31)] = v; }
    LDS_WAIT(); asm volatile("" ::: "memory");
    const int c = lane & 7;
#pragma unroll
    for (int j = 0; j < 4; ++j) { const int n = (lane >> 3) + 8 * j; const LAS float* s = scr + (8 * c) * 33 + n;
        u32x4 o; o.x = cvt_pk_bf16(s[0 * 33], s[1 * 33]); o.y = cvt_pk_bf16(s[2 * 33], s[3 * 33]); o.z = cvt_pk_bf16(s[4 * 33], s[5 * 33]); o.w = cvt_pk_bf16(s[6 * 33], s[7 * 33]);
        *(GAS u32x4*)(WT + (size_t)row_map<MAP>(n0 + n) * ldt + koff + k0 + 8 * c) = o; }
    LDS_WAIT(); asm volatile("" ::: "memory");
}
__device__ __forceinline__ void rms_row_to_bf16(const float* xrow, const float* g, bf16_t* orow, int lane) {
    const GAS f32x4* xr = (const GAS f32x4*)xrow + lane; const GAS f32x4* gr = (const GAS f32x4*)g + lane;
    f32x4 v[8]; float s = 0.f;
#pragma unroll
    for (int j = 0; j < 8; ++j) { v[j] = xr[64 * j]; s += (v[j].x * v[j].x + v[j].y * v[j].y) + (v[j].z * v[j].z + v[j].w * v[j].w); }
    const float r = 1.0f / sqrtf(wave_sum(s) * (1.f / D_MODEL) + EPS);
    GAS u32x2* o8 = (GAS u32x2*)orow + lane;
#pragma unroll
    for (int j = 0; j < 8; ++j) { const f32x4 gg = gr[64 * j]; u32x2 w; w.x = cvt_pk_bf16(v[j].x * r * gg.x, v[j].y * r * gg.y); w.y = cvt_pk_bf16(v[j].z * r * gg.z, v[j].w * r * gg.w); o8[64 * j] = w; }
}

struct EpiBig {
    unsigned char* ws; const float* cosT; const float* sinT;
    __device__ __forceinline__ void operator()(const f32x4 (&acc)[2][2][4][2], const pg8::Unit& u, int ui, int wr, int wc, int fr, int fq) const {
        const int pn = u.pn, rb = u.pm * 256;
        if (pn >= 52) { pg8::store_tile<0>(acc, (bf16_t*)(ws + WS_MKV) + (pn - 52) * 256, 1024, rb - NTOK, wr, wc, fr, fq, 1.f, nullptr); return; }
        if (pn < 4)  { pg8::store_tile<0>(acc, (bf16_t*)(ws + WS_QA) + pn * 256, 1024, rb, wr, wc, fr, fq, C2A, nullptr); return; }
        if (pn < 8)  { pg8::store_tile<0>(acc, (bf16_t*)(ws + WS_KA) + (pn - 4) * 256, 1024, rb, wr, wc, fr, fq, 1.f, nullptr); return; }
        if (pn < 12) { pg8::store_tile<0>(acc, (bf16_t*)(ws + WS_VA) + (pn - 8) * 256, 1024, rb, wr, wc, fr, fq, 1.f, nullptr); return; }
        if (pn < 16) { pg8::store_tile<1>(acc, (bf16_t*)(ws + WS_ZA) + (pn - 12) * 256, 1024, rb, wr, wc, fr, fq, 1.f, nullptr); return; }
        if (pn < 18) { pg8::store_tile<3>(acc, (bf16_t*)(ws + WS_CQ) + (pn - 16) * 256, 512, rb, wr, wc, fr, fq, 1.f, (float*)(ws + WS_CTL) + CW_SSQP + (pn - 16) * 4); return; }
        if (pn == 18) { pg8::store_tile<3>(acc, (bf16_t*)(ws + WS_CKV), 256, rb, wr, wc, fr, fq, 1.f, (float*)(ws + WS_CTL) + CW_SSQP + 8); return; }
        if (pn == 19) {
            if (wc < 2) {
                const int g = 4 * wc + fq; bf16_t* kb = (bf16_t*)(ws + WS_KB);
#pragma unroll
                for (int ai = 0; ai < 2; ++ai)
#pragma unroll
                    for (int m = 0; m < 4; ++m) {
                        const int row = rb + wr * 64 + fr + ai * 128 + m * 16, pos = row & (SEQ - 1);
                        const f32x4 x1 = acc[ai][0][m][0], x2 = acc[ai][0][m][1];
                        const f32x4 cs = *(const f32x4*)(cosT + pos * 32 + 4 * g), sn = *(const f32x4*)(sinT + pos * 32 + 4 * g);
                        const f32x4 o1 = x1 * cs - x2 * sn, o2 = x2 * cs + x1 * sn;
                        u32x2 w1, w2; w1.x = cvt_pk_bf16(o1[0], o1[1]); w1.y = cvt_pk_bf16(o1[2], o1[3]); w2.x = cvt_pk_bf16(o2[0], o2[1]); w2.y = cvt_pk_bf16(o2[2], o2[3]);
                        bf16_t* p = kb + (size_t)row * 1536 + 128 + 4 * g;
#pragma unroll
                        for (int h = 0; h < 8; ++h) { *(u32x2*)(p + h * 192) = w1; *(u32x2*)(p + h * 192 + 32) = w2; }
                    }
            }
            return;
        }
        if (pn < 24) { pg8::store_tile<1>(acc, (bf16_t*)(ws + WS_ZB) + (pn - 20) * 256, 1024, rb, wr, wc, fr, fq, 1.f, nullptr); return; }
        if (pn < 26) { pg8::store_tile<0>(acc, (bf16_t*)(ws + WS_QM) + (pn - 24) * 256, 512, rb, wr, wc, fr, fq, C2A, nullptr); return; }
        if (pn < 28) { pg8::store_tile<1>(acc, (bf16_t*)(ws + WS_ZM) + (pn - 26) * 256, 512, rb, wr, wc, fr, fq, 1.f, nullptr); return; }
        if (pn < 36) { pg8::store_tile<2>(acc, (bf16_t*)(ws + WS_GLA) + (pn - 28) * 256, 2048, rb, wr, wc, fr, fq, 1.f, nullptr); return; }
        if (pn < 44) { pg8::store_tile<2>(acc, (bf16_t*)(ws + WS_GLB) + (pn - 36) * 256, 2048, rb, wr, wc, fr, fq, 1.f, nullptr); return; }
        pg8::store_tile<2>(acc, (bf16_t*)(ws + WS_GLM) + (pn - 44) * 256, 2048, rb, wr, wc, fr, fq, 1.f, nullptr);
    }
};
struct EpiQup {
    unsigned char* ws; const float* cosT; const float* sinT;
    __device__ __forceinline__ void operator()(const f32x4 (&acc)[2][2][4][2], const pg8::Unit& u, int ui, int wr, int wc, int fr, int fq) const {
        const float* ssq = (const float*)(ws + WS_CTL) + CW_SSQP; bf16_t* qb = (bf16_t*)(ws + WS_QB);
        const int pn = u.pn, row0 = u.pm * 256 + wr * 64 + fr;
        if (pn < 4) {
#pragma unroll
            for (int ai = 0; ai < 2; ++ai)
#pragma unroll
                for (int m = 0; m < 4; ++m) {
                    const int row = row0 + ai * 128 + m * 16;
                    const f32x4 sa = *(const f32x4*)(ssq + (size_t)row * 16), sb = *(const f32x4*)(ssq + (size_t)row * 16 + 4);
                    const float rs = C2B / sqrtf((((sa[0] + sa[1]) + (sa[2] + sa[3])) + ((sb[0] + sb[1]) + (sb[2] + sb[3]))) * (1.f / 512.f) + EPS);
#pragma unroll
                    for (int bj = 0; bj < 2; ++bj) {
                        const f32x4 v0 = acc[ai][bj][m][0] * rs, v1 = acc[ai][bj][m][1] * rs;
                        u32x4 w; w.x = cvt_pk_bf16(v0[0], v0[1]); w.y = cvt_pk_bf16(v0[2], v0[3]); w.z = cvt_pk_bf16(v1[0], v1[1]); w.w = cvt_pk_bf16(v1[2], v1[3]);
                        *(u32x4*)(qb + (size_t)row * 1536 + (pn * 2 + bj) * 192 + 32 * wc + 8 * fq) = w;
                    }
                    asm volatile("" ::: "memory");
                }
        } else {
            const int g = 4 * (wc & 1) + fq;
#pragma unroll
            for (int ai = 0; ai < 2; ++ai)
#pragma unroll
                for (int m = 0; m < 4; ++m) {
                    const int row = row0 + ai * 128 + m * 16, pos = row & (SEQ - 1);
                    const f32x4 sa = *(const f32x4*)(ssq + (size_t)row * 16), sb = *(const f32x4*)(ssq + (size_t)row * 16 + 4);
                    const float rs = C2B / sqrtf((((sa[0] + sa[1]) + (sa[2] + sa[3])) + ((sb[0] + sb[1]) + (sb[2] + sb[3]))) * (1.f / 512.f) + EPS);
                    const f32x4 cs = *(const f32x4*)(cosT + pos * 32 + 4 * g), sn = *(const f32x4*)(sinT + pos * 32 + 4 * g);
#pragma unroll
                    for (int bj = 0; bj < 2; ++bj) {
                        const f32x4 v0 = acc[ai][bj][m][0] * rs, v1 = acc[ai][bj][m][1] * rs;
                        const int h = (pn - 4) * 4 + 2 * bj + (wc >> 1);
                        const f32x4 o1 = v0 * cs - v1 * sn, o2 = v1 * cs + v0 * sn;
                        u32x2 w1, w2; w1.x = cvt_pk_bf16(o1[0], o1[1]); w1.y = cvt_pk_bf16(o1[2], o1[3]); w2.x = cvt_pk_bf16(o2[0], o2[1]); w2.y = cvt_pk_bf16(o2[2], o2[3]);
                        bf16_t* p = qb + (size_t)row * 1536 + h * 192 + 128 + 4 * g;
                        *(u32x2*)p = w1; *(u32x2*)(p + 32) = w2;
                    }
                    asm volatile("" ::: "memory");
                }
        }
    }
};
struct EpiKVup {
    unsigned char* ws;
    __device__ __forceinline__ void operator()(const f32x4 (&acc)[2][2][4][2], const pg8::Unit& u, int ui, int wr, int wc, int fr, int fq) const {
        const float* ssq = (const float*)(ws + WS_CTL) + CW_SSQP; bf16_t* kb = (bf16_t*)(ws + WS_KB); bf16_t* vb = (bf16_t*)(ws + WS_VB);
        const int h = u.pn, j = 32 * wc + 8 * fq;
#pragma unroll
        for (int ai = 0; ai < 2; ++ai)
#pragma unroll
            for (int m = 0; m < 4; ++m) {
                const int row = u.pm * 256 + wr * 64 + fr + ai * 128 + m * 16;
                const f32x4 sa = *(const f32x4*)(ssq + (size_t)row * 16 + 8);
                const float rs = 1.0f / sqrtf(((sa[0] + sa[1]) + (sa[2] + sa[3])) * (1.f / 256.f) + EPS);
#pragma unroll
                for (int bj = 0; bj < 2; ++bj) {
                    const f32x4 v0 = acc[ai][bj][m][0] * rs, v1 = acc[ai][bj][m][1] * rs;
                    u32x4 w; w.x = cvt_pk_bf16(v0[0], v0[1]); w.y = cvt_pk_bf16(v0[2], v0[3]); w.z = cvt_pk_bf16(v1[0], v1[1]); w.w = cvt_pk_bf16(v1[2], v1[3]);
                    if (bj == 0) *(u32x4*)(kb + (size_t)row * 1536 + h * 192 + j) = w; else *(u32x4*)(vb + (size_t)row * 1024 + h * 128 + j) = w;
                }
                asm volatile("" ::: "memory");
            }
    }
};
template <int PASS> struct EpiMerge {
    const bf16_t* sig; bf16_t* Y;
    __device__ __forceinline__ void operator()(const f32x4 (&acc)[2][2][4][2], const pg8::Unit& u, int ui, int wr, int wc, int fr, int fq) const {
        const int col0 = u.pn * 256 + wc * 32 + 8 * fq;
#pragma unroll
        for (int ai = 0; ai < 2; ++ai)
#pragma unroll
            for (int m = 0; m < 4; ++m) {
                const size_t off = (size_t)(u.pm * 256 + wr * 64 + fr + ai * 128 + m * 16) * 2048 + col0;
#pragma unroll
                for (int bj = 0; bj < 2; ++bj) {
                    const u32x4 s = *(const u32x4*)(sig + off + bj * 128);
                    f32x4 v0 = acc[ai][bj][m][0], v1 = acc[ai][bj][m][1];
                    v0[0] *= bflo(s.x); v0[1] *= bfhi(s.x); v0[2] *= bflo(s.y); v0[3] *= bfhi(s.y); v1[0] *= bflo(s.z); v1[1] *= bfhi(s.z); v1[2] *= bflo(s.w); v1[3] *= bfhi(s.w);
                    if (PASS > 0) { const u32x4 y = *(const u32x4*)(Y + off + bj * 128);
                        v0[0] += bflo(y.x); v0[1] += bfhi(y.x); v0[2] += bflo(y.y); v0[3] += bfhi(y.y); v1[0] += bflo(y.z); v1[1] += bfhi(y.z); v1[2] += bflo(y.w); v1[3] += bfhi(y.w); }
                    u32x4 w; w.x = cvt_pk_bf16(v0[0], v0[1]); w.y = cvt_pk_bf16(v0[2], v0[3]); w.z = cvt_pk_bf16(v1[0], v1[1]); w.w = cvt_pk_bf16(v1[2], v1[3]);
                    *(u32x4*)(Y + off + bj * 128) = w;
                }
            }
    }
};
struct EpiOut {
    const float* x; float* out;
    __device__ __forceinline__ void operator()(const f32x4 (&acc)[2][2][4][2], const pg8::Unit& u, int ui, int wr, int wc, int fr, int fq) const {
        const int col0 = u.pn * 256 + wc * 32 + 8 * fq;
#pragma unroll
        for (int ai = 0; ai < 2; ++ai)
#pragma unroll
            for (int m = 0; m < 4; ++m) {
                const size_t off = (size_t)(u.pm * 256 + wr * 64 + fr + ai * 128 + m * 16) * 2048 + col0;
#pragma unroll
                for (int bj = 0; bj < 2; ++bj) {
                    const f32x4 a0 = *(const f32x4*)(x + off + bj * 128), a1 = *(const f32x4*)(x + off + bj * 128 + 4);
                    *(f32x4*)(out + off + bj * 128) = a0 + acc[ai][bj][m][0]; *(f32x4*)(out + off + bj * 128 + 4) = a1 + acc[ai][bj][m][1];
                }
            }
    }
};

__global__ void __launch_bounds__(NWAVES * 64, 2) mk_fwd(Args args) {
    extern __shared__ __attribute__((aligned(16))) unsigned char lds[];
    LAS unsigned char* ldsl = (LAS unsigned char*)lds;
    volatile LAS unsigned* MISC = (volatile LAS unsigned*)(ldsl + MISC_OFF);
    const int tid = threadIdx.x, lane = tid & 63, wave = __builtin_amdgcn_readfirstlane(tid >> 6);
    const int G = gridDim.x; const int bx = blockIdx.x; const int vcu = (G % 8 == 0) ? (bx % 8) * (G / 8) + bx / 8 : bx;
    unsigned char* ws = args.ws;
    for (int u = tid; u < (LDS_BYTES - LDSCTL_OFF) / 4; u += NWAVES * 64) ((LAS unsigned*)(ldsl + LDSCTL_OFF))[u] = 0u;
    __syncthreads();
    XcdBarrier bar; bar.bar = (unsigned*)(ws + WS_CTL) + CW_BAR; bar.x = 0; bar.st = nullptr;
    if (N_LAUNCHES == 1) bar = xcd_barrier_post((unsigned*)(ws + WS_CTL) + CW_BAR, MISC + 8);
    const int lo = args.ph_lo, hi = args.ph_hi;
#ifndef PHMASK
#define PHMASK 0x7f
#endif
#define IN(k) (((PHMASK >> (k)) & 1) && lo <= (k) && (k) < hi)
#define GRID_BAR() do { if (N_LAUNCHES == 1) xcd_barrier(bar); } while (0)
    float* cosT = (float*)(ws + WS_TAB + TAB_COS); float* sinT = (float*)(ws + WS_TAB + TAB_SIN);
    float* lutG = (float*)(ws + WS_TAB + TAB_LUT); float* kmeanG = (float*)(ws + WS_TAB + TAB_KMEAN);

    if (IN(0)) {
        LAS float* scr = (LAS float*)(ldsl + wave * 16384);
        const int gw = vcu * NWAVES + wave, NGW = G * NWAVES;
        constexpr int I_IN = 32 * (IN_WIDTH / 32), I_UQ = 8 * 48, I_UKV = 4 * 64, I_MEM = 32 * 32, I_PA = 16 * 64, I_PB = 16 * 64, I_PM = 8 * 64, I_OUT = 32 * 64;
        constexpr int NITEMS = I_IN + I_UQ + I_UKV + I_MEM + I_PA + I_PB + I_PM + I_OUT;
        for (int it = gw; it < NITEMS; it += NGW) {
            int r = it;
            if (r < I_IN) { p0_transpose_item<1>(args.w_in, IN_WIDTH, (bf16_t*)(ws + WS_WINT), 2048, 0, nullptr, scr, r, lane); continue; } r -= I_IN;
            if (r < I_UQ) { p0_transpose_item<2>(args.w_uq, 1536, (bf16_t*)(ws + WS_WUQT), 512, 0, args.g_cq, scr, r, lane); continue; } r -= I_UQ;
            if (r < I_UKV) { p0_transpose_item<0>(args.w_ukv, 2048, (bf16_t*)(ws + WS_WUKVT), 256, 0, args.g_ckv, scr, r, lane); continue; } r -= I_UKV;
            if (r < I_MEM) { p0_transpose_item<0>(args.w_mem_kv, 1024, (bf16_t*)(ws + WS_WMEMT), 2048, 0, nullptr, scr, r, lane); continue; } r -= I_MEM;
            if (r < I_PA) { p0_transpose_item<0>(args.w_p_moba, 2048, (bf16_t*)(ws + WS_WPT), 2560, 0, nullptr, scr, r, lane); continue; } r -= I_PA;
            if (r < I_PB) { p0_transpose_item<0>(args.w_p_mla, 2048, (bf16_t*)(ws + WS_WPT), 2560, 1024, nullptr, scr, r, lane); continue; } r -= I_PB;
            if (r < I_PM) { p0_transpose_item<0>(args.w_p_mem, 2048, (bf16_t*)(ws + WS_WPT), 2560, 2048, nullptr, scr, r, lane); continue; } r -= I_PM;
            p0_transpose_item<0>(args.w_out, 2048, (bf16_t*)(ws + WS_WOUTT), 2048, 0, nullptr, scr, r, lane);
        }
        for (int m = gw; m < NTOK; m += NGW) rms_row_to_bf16(args.x + (size_t)m * D_MODEL, args.g_norm, (bf16_t*)(ws + WS_H) + (size_t)m * D_MODEL, lane);
        for (int m = gw; m < BATCH * MEMT; m += NGW) rms_row_to_bf16(args.mem + (size_t)m * D_MODEL, args.g_mem, (bf16_t*)(ws + WS_MB) + (size_t)m * D_MODEL, lane);
        const int gt = vcu * (NWAVES * 64) + tid, NGT = G * NWAVES * 64;
        for (int i = gt; i < SEQ * 32; i += NGT) { const int pos = i >> 5, k = i & 31; const float inv = powf(10000.0f, -(float)k / 32.0f); const float ang = (float)pos * inv; cosT[i] = cosf(ang); sinT[i] = sinf(ang); }
        for (int i = gt; i < 8 * 320; i += NGT) { const int h = i / 320, idx = i - h * 320; int dist = idx - 96; if (dist < 0) dist = 0;
            const int bk = dist >= 128 ? 31 : (int)T5_BUCKET[dist];
            lutG[i] = args.rel_bias[bk * 8 + h] * LOG2E; }
        for (int i = gt; i < 192 * 2048 / 8; i += NGT) ((GAS u32x4*)((bf16_t*)(ws + WS_WINT) + (size_t)4928 * 2048))[i] = (u32x4){0u, 0u, 0u, 0u};
        GRID_BAR();
    }

    if (IN(1)) {
        pg8::Gemm g{(const bf16_t*)(ws + WS_H), (const bf16_t*)(ws + WS_WINT), 2048, 2048, 2048};
        pg8::StaticOrder S; S.init(NTOK / 256, NPAD / 256, G, bx); S.extra = 16; S.extra_pm0 = 32; S.extra_pn0 = 52; S.extra_nn = 4;
        EpiBig E{ws, cosT, sinT};
        pg8::gemm_phase<EpiBig, pg8::StaticOrder>(ldsl, g, S, E);
        GRID_BAR();
    }

    if (IN(2)) {
        {
            for (int item = vcu; item < 256; item += G) {
                const int b = item >> 6, h = (item >> 3) & 7, n = item & 7;
                const bf16_t* kp = (const bf16_t*)(ws + WS_KA) + (size_t)(b * SEQ + n * 256) * 1024 + h * 128;
                const int c = tid & 15, kg = tid >> 4;
                float s[8] = {0.f, 0.f, 0.f, 0.f, 0.f, 0.f, 0.f, 0.f};
#pragma unroll
                for (int k = 0; k < 8; ++k) { const u32x4 w = *(const u32x4*)(kp + (size_t)(kg * 8 + k) * 1024 + c * 8);
                    s[0] += bflo(w.x); s[1] += bfhi(w.x); s[2] += bflo(w.y); s[3] += bfhi(w.y); s[4] += bflo(w.z); s[5] += bfhi(w.z); s[6] += bflo(w.w); s[7] += bfhi(w.w); }
                LAS float* red = (LAS float*)ldsl;
#pragma unroll
                for (int e = 0; e < 8; ++e) red[kg * 128 + c * 8 + e] = s[e];
                __syncthreads();
                if (tid < 128) { float a = 0.f;
#pragma unroll 8
                    for (int q = 0; q < 32; ++q) a += red[q * 128 + tid];
                    kmeanG[item * 128 + tid] = a * (1.0f / 256.0f); }
                __syncthreads();
            }
        }
        {   pg8::Gemm g{(const bf16_t*)(ws + WS_CKV), (const bf16_t*)(ws + WS_WUKVT), 256, 256, 256};
            pg8::StaticOrder S; S.init(NTOK / 256, 8, G, bx);
            EpiKVup E{ws};
            pg8::gemm_phase<EpiKVup, pg8::StaticOrder>(ldsl, g, S, E); }
        {   pg8::Gemm g{(const bf16_t*)(ws + WS_CQ), (const bf16_t*)(ws + WS_WUQT), 512, 512, 512};
            pg8::StaticOrder S; S.init(NTOK / 256, 6, G, bx);
            EpiQup E{ws, cosT, sinT};
            pg8::gemm_phase<EpiQup, pg8::StaticOrder>(ldsl, g, S, E); }
        GRID_BAR();
    }

    if (IN(3)) {
        bf16_t* Gb = (bf16_t*)(ws + WS_G);
        for (int v = vcu; v < 256; v += G) {
#ifndef ATTMASK
#define ATTMASK 7
#endif
            if (v < 128) { if (ATTMASK & 1) {
                const int bh = v >> 2, s = v & 3, b = bh >> 3, h = bh & 7;
                att::BlockRef r[2];
#pragma unroll
                for (int i = 0; i < 2; ++i) { const int qb = i == 0 ? s : 7 - s; const size_t row0 = (size_t)b * SEQ + qb * 256;
                    r[i].Q = (const bf16_t*)(ws + WS_QB) + row0 * 1536 + h * 192; r[i].ldq = 1536;
                    r[i].K = (const bf16_t*)(ws + WS_KB) + (size_t)b * SEQ * 1536 + h * 192; r[i].ldk = 1536;
                    r[i].V = (const bf16_t*)(ws + WS_VB) + (size_t)b * SEQ * 1024 + h * 128; r[i].ldv = 1024;
                    r[i].Z = (const bf16_t*)(ws + WS_ZB) + row0 * 1024 + h * 128; r[i].ldz = 1024;
                    r[i].O = Gb + row0 * 2560 + 1024 + h * 128; r[i].P0 = qb * 256; r[i].nt = 4 * (qb + 1); r[i].kmean = nullptr; r[i].lut = nullptr; }
                att::Seam<192> S;
                att::attn_prime<192>(r[0], (char*)lds, S);
                att::BlockRef cur = r[0], nxt = r[1];
#pragma unroll 1
                for (int i = 0; i < 2; ++i) { att::attn_block<192, 1>(cur, nxt, (char*)lds, S); cur = nxt; } }
            } else {
                const int pi = v - 128, bh = pi >> 2, s = pi & 3, b = bh >> 3, h = bh & 7;
                att::BlockRef r[3];
#pragma unroll
                for (int i = 0; i < 2; ++i) { const int qb = i == 0 ? s : 7 - s; const size_t row0 = (size_t)b * SEQ + qb * 256;
                    r[i].Q = (const bf16_t*)(ws + WS_QA) + row0 * 1024 + h * 128; r[i].ldq = 1024;
                    r[i].K = (const bf16_t*)(ws + WS_KA) + (size_t)b * SEQ * 1024 + h * 128; r[i].ldk = 1024;
                    r[i].V = (const bf16_t*)(ws + WS_VA) + (size_t)b * SEQ * 1024 + h * 128; r[i].ldv = 1024;
                    r[i].Z = (const bf16_t*)(ws + WS_ZA) + row0 * 1024 + h * 128; r[i].ldz = 1024;
                    r[i].O = Gb + row0 * 2560 + h * 128; r[i].P0 = qb * 256; r[i].nt = 4 * (qb + 1);
                    r[i].kmean = kmeanG + (size_t)(b * 8 + h) * 1024; r[i].lut = lutG + h * 320; }
                {   const int bm = pi >> 5, hm = (pi >> 3) & 3, qb = pi & 7; const size_t row0 = (size_t)bm * SEQ + qb * 256;
                    r[2].Q = (const bf16_t*)(ws + WS_QM) + row0 * 512 + hm * 128; r[2].ldq = 512;
                    r[2].K = (const bf16_t*)(ws + WS_MKV) + (size_t)bm * MEMT * 1024 + hm * 128; r[2].ldk = 1024;
                    r[2].V = (const bf16_t*)(ws + WS_MKV) + (size_t)bm * MEMT * 1024 + 512 + hm * 128; r[2].ldv = 1024;
                    r[2].Z = (const bf16_t*)(ws + WS_ZM) + row0 * 512 + hm * 128; r[2].ldz = 512;
                    r[2].O = Gb + row0 * 2560 + 2048 + hm * 128; r[2].P0 = qb * 256; r[2].nt = 4; r[2].kmean = nullptr; r[2].lut = nullptr; }
                att::Seam<128> S;
                att::attn_prime<128>(r[0], (char*)lds, S);
                att::BlockRef cur = r[0], nxt = r[1];
#pragma unroll 1
                for (int i = 0; i < ((ATTMASK & 2) ? 2 : 0); ++i) { att::attn_block<128, 0>(cur, nxt, (char*)lds, S); cur = nxt; nxt = r[2]; }
                if (ATTMASK & 4) att::attn_block<128, 2>(r[2], r[2], (char*)lds, S);
            }
        }
        VM_WAIT(); __syncthreads();
        GRID_BAR();
    }

    if (IN(4)) {
        pg8::StaticOrder S; S.init(NTOK / 256, 8, G, bx);
        const bf16_t* Gb = (const bf16_t*)(ws + WS_G); const bf16_t* Wp = (const bf16_t*)(ws + WS_WPT); bf16_t* Y = (bf16_t*)(ws + WS_Y);
        {   pg8::Gemm g{Gb, Wp, 1024, 2560, 2560}; EpiMerge<0> E{(const bf16_t*)(ws + WS_GLA), Y}; pg8::gemm_phase<EpiMerge<0>, pg8::StaticOrder>(ldsl, g, S, E); }
        VM_WAIT(); __syncthreads();
        {   pg8::Gemm g{Gb + 1024, Wp + 1024, 1024, 2560, 2560}; EpiMerge<1> E{(const bf16_t*)(ws + WS_GLB), Y}; pg8::gemm_phase<EpiMerge<1>, pg8::StaticOrder>(ldsl, g, S, E); }
        VM_WAIT(); __syncthreads();
        {   pg8::Gemm g{Gb + 2048, Wp + 2048, 512, 2560, 2560}; EpiMerge<1> E{(const bf16_t*)(ws + WS_GLM), Y}; pg8::gemm_phase<EpiMerge<1>, pg8::StaticOrder>(ldsl, g, S, E); }
        GRID_BAR();
    }

    if (IN(5)) {
        pg8::Gemm g{(const bf16_t*)(ws + WS_Y), (const bf16_t*)(ws + WS_WOUTT), 2048, 2048, 2048};
        pg8::StaticOrder S; S.init(NTOK / 256, 8, G, bx);
        EpiOut E{args.x, args.out};
        pg8::gemm_phase<EpiOut, pg8::StaticOrder>(ldsl, g, S, E);
        GRID_BAR();
    }

    if (IN(6)) {
        const int gw = vcu * NWAVES + wave, NGW = G * NWAVES;
        const unsigned tmo = __hip_atomic_load((unsigned*)(ws + WS_CTL) + CW_BAR + XB_TMO, RLX_AGENT);
        for (int m = gw; m < NTOK; m += NGW) {
            GAS f32x4* xr = (GAS f32x4*)(args.out + (size_t)m * D_MODEL) + lane; const GAS f32x4* gr = (const GAS f32x4*)args.g_final + lane;
            f32x4 v[8]; float s = 0.f;
#pragma unroll
            for (int j = 0; j < 8; ++j) { v[j] = xr[64 * j]; s += (v[j].x * v[j].x + v[j].y * v[j].y) + (v[j].z * v[j].z + v[j].w * v[j].w); }
            float r = 1.0f / sqrtf(wave_sum(s) * (1.f / D_MODEL) + EPS);
            if (tmo) r = __builtin_nanf("");
#pragma unroll
            for (int j = 0; j < 8; ++j) xr[64 * j] = v[j] * r * gr[64 * j];
        }
    }
#undef IN
#undef GRID_BAR
}


#ifdef DIAG
__global__ void chk_k(const unsigned* buf, size_t nwords, unsigned long long* acc) {
    unsigned long long sum = 0;
    for (size_t i = (size_t)blockIdx.x * blockDim.x + threadIdx.x; i < nwords; i += (size_t)gridDim.x * blockDim.x) sum += (unsigned long long)buf[i] * (unsigned long long)(1 + (i & 1023));
    for (int o = 32; o > 0; o >>= 1) sum += __shfl_xor(sum, o);
    if ((threadIdx.x & 63) == 0) atomicAdd(acc, sum);
}
__global__ void diag_final_k(const unsigned long long* chk, float* out, size_t n) {
    const size_t i = (size_t)blockIdx.x * blockDim.x + threadIdx.x;
    if (i >= n) return;
    float v = 0.f;
    if (i == 0) {
        int first = -1, cnt = 0;
        int mask = 0; for (int b = 9; b < 14; ++b) if (chk[0 * 16 + b] != chk[1 * 16 + b]) { if (first < 0) first = b; ++cnt; mask |= 1 << (b - 9); }
        v = 100.f * (float)(mask + 32);
    }
    out[i] = v;
}
#endif

extern "C" void kernel_launch(void* const* d_in, const int* in_sizes, int n_in, void* d_out, int out_size, void* d_ws, size_t ws_size, hipStream_t stream) {
    static int grid = 0;
    if (grid == 0) {
        if (n_in != 16 || in_sizes[0] != NTOK * D_MODEL || out_size != NTOK * D_MODEL || ws_size < WS_END) {
            fprintf(stderr, "kernel_launch: unexpected shapes (n_in %d, in0 %d, out %d, ws %zu need %zu); nothing launched\n", n_in, n_in > 0 ? in_sizes[0] : -1, out_size, ws_size, (size_t)WS_END);
            grid = -1; return; }
        int dev = 0, cus = 0, per_cu = 0;
        if (hipGetDevice(&dev) != hipSuccess || hipDeviceGetAttribute(&cus, hipDeviceAttributeMultiprocessorCount, dev) != hipSuccess) { fprintf(stderr, "kernel_launch: device query failed\n"); grid = -1; return; }
        if (hipFuncSetAttribute((const void*)mk_fwd, hipFuncAttributeMaxDynamicSharedMemorySize, LDS_BYTES) != hipSuccess) { fprintf(stderr, "kernel_launch: hipFuncSetAttribute failed\n"); grid = -1; return; }
        if (hipOccupancyMaxActiveBlocksPerMultiprocessor(&per_cu, (const void*)mk_fwd, NWAVES * 64, LDS_BYTES) != hipSuccess || per_cu < 1) {
            fprintf(stderr, "kernel_launch: occupancy query reports %d workgroups per CU\n", per_cu); (void)hipGetLastError(); }
        grid = cus;
    }
    if (grid < 0) return;
    if (hipMemsetAsync((char*)d_ws + WS_CTL, 0, CTL_ZERO_BYTES, stream) != hipSuccess) { fprintf(stderr, "kernel_launch: memset failed\n"); return; }
    Args a{};
    a.x = (const float*)d_in[0]; a.mem = (const float*)d_in[1]; a.g_norm = (const float*)d_in[2]; a.w_in = (const float*)d_in[3]; a.g_cq = (const float*)d_in[4];
    a.w_uq = (const float*)d_in[5]; a.g_ckv = (const float*)d_in[6]; a.w_ukv = (const float*)d_in[7]; a.g_mem = (const float*)d_in[8]; a.w_mem_kv = (const float*)d_in[9];
    a.rel_bias = (const float*)d_in[10]; a.w_p_moba = (const float*)d_in[11]; a.w_p_mla = (const float*)d_in[12]; a.w_p_mem = (const float*)d_in[13]; a.w_out = (const float*)d_in[14];
    a.g_final = (const float*)d_in[15]; a.out = (float*)d_out; a.ws = (unsigned char*)d_ws;
#ifdef DIAG
    {
        unsigned char* w = (unsigned char*)d_ws; unsigned long long* chk = (unsigned long long*)(w + 400 * MiB);
        hipMemsetAsync(chk, 0, 2 * 16 * 8, stream);
        auto CK = [&](int run, int b, const void* base, size_t bytes) { chk_k<<<2048, 256, 0, stream>>>((const unsigned*)base, bytes / 4, chk + run * 16 + b); };
        hipMemsetAsync((char*)d_ws + WS_CTL, 0, CTL_ZERO_BYTES, stream);
        a.ph_lo = 0; a.ph_hi = 1; hipLaunchKernelGGL(mk_fwd, dim3(grid), dim3(NWAVES * 64), LDS_BYTES, stream, a);
        for (int run = 0; run < 2; ++run) {
            a.ph_lo = 1; a.ph_hi = 2; hipLaunchKernelGGL(mk_fwd, dim3(grid), dim3(NWAVES * 64), LDS_BYTES, stream, a);
            CK(run, 0, w + WS_QA, 16 * MiB); CK(run, 1, w + WS_KA, 16 * MiB); CK(run, 2, w + WS_VA, 16 * MiB); CK(run, 3, w + WS_ZA, 16 * MiB);
            CK(run, 4, w + WS_CQ, 8 * MiB); CK(run, 5, w + WS_CKV, 4 * MiB); CK(run, 6, w + WS_ZB, 16 * MiB); CK(run, 7, w + WS_QM, 8 * MiB); CK(run, 8, w + WS_ZM, 8 * MiB);
            CK(run, 9, w + WS_GLA, 32 * MiB); CK(run, 10, w + WS_GLB, 32 * MiB); CK(run, 11, w + WS_GLM, 32 * MiB); CK(run, 12, w + WS_MKV, 2 * MiB); CK(run, 13, w + WS_CTL + CW_SSQP * 4, 8192 * 16 * 4);
        }
        diag_final_k<<<(NTOK * D_MODEL + 255) / 256, 256, 0, stream>>>(chk, (float*)d_out, (size_t)NTOK * D_MODEL);
    }
#else
    if (N_LAUNCHES == 1) {
        a.ph_lo = 0; a.ph_hi = N_PHASES;
        hipLaunchKernelGGL(mk_fwd, dim3(grid), dim3(NWAVES * 64), LDS_BYTES, stream, a);
    } else {
        for (int p = 0; p < N_PHASES; ++p) { a.ph_lo = p; a.ph_hi = p + 1; hipLaunchKernelGGL(mk_fwd, dim3(grid), dim3(NWAVES * 64), LDS_BYTES, stream, a); }
    }
#endif
    const hipError_t le = hipPeekAtLastError();
    if (le != hipSuccess) fprintf(stderr, "kernel_launch: launch failed: %s\n", hipGetErrorName(le));
}
```
